# Optimizing an MI355X kernel written in HIP

```python
import math
import jax, jax.numpy as jnp
from jax import lax
import numpy as np

D_MODEL = 1024
BATCH = 8
SEQ = 2048
DEPTH = 1
DEC_BATCH = 128
DEC_SEQ = 4
PAST_LEN = 16384
PAGE_SIZE = 128

GM_WIDTH = D_MODEL
GM_GROUPS = 8
GM_GROUP_DIM = GM_WIDTH // GM_GROUPS
GM_CHUNK = 128
DN_HEADS = 8
DN_HEAD_DIM = D_MODEL // DN_HEADS
DN_WIDTH = DN_HEADS * DN_HEAD_DIM
DN_CONV = 4
DN_CHUNK = 64
D_FF = 2816
IN_COLS = 2 * GM_WIDTH + 4 * DN_WIDTH + 2 * DN_HEADS + 2 * D_MODEL
ALPHA = (2.0 * DEPTH) ** 0.25
BETA_INIT = (8.0 * DEPTH) ** -0.25
LN_EPS = 1e-5
RMS_EPS = 1e-6

kernel_name = 'hybrid_gmlp_gdn_macaron_deepnorm_step'


def layer_norm(x, g, b):
    x32 = x.astype(jnp.float32)
    mu = jnp.mean(x32, axis=-1, keepdims=True)
    var = jnp.mean(jnp.square(x32 - mu), axis=-1, keepdims=True)
    return ((x32 - mu) * lax.rsqrt(var + LN_EPS) * g + b).astype(x.dtype)


def rms_norm(x, w):
    x32 = x.astype(jnp.float32)
    return x32 * lax.rsqrt(jnp.mean(jnp.square(x32), axis=-1, keepdims=True) + RMS_EPS) * w


def l2_normalize(x):
    return x * lax.rsqrt(jnp.sum(jnp.square(x), axis=-1, keepdims=True) + RMS_EPS)


def swiglu_ffn(x, w_up, w_down):
    a, gt = jnp.split(x @ w_up, 2, axis=-1)
    return (jax.nn.silu(a) * gt) @ w_down


def chunk_spatial_mix(v, w_s, b_s):
    B, T, _ = v.shape
    L = min(GM_CHUNK, T)
    vc = v.reshape(B, T // L, L, GM_GROUPS, GM_GROUP_DIM)
    w = jnp.tril(w_s[:, :L, :L])
    mixed = jnp.einsum('gts,bcsgd->bctgd', w, vc) + b_s[:, :L].T[None, None, :, :, None]
    return mixed.reshape(B, T, GM_WIDTH)


def _to_chunks(a, n, L, pad):
    a = jnp.pad(a, [(0, 0), (0, pad)] + [(0, 0)] * (a.ndim - 2))
    a = a.reshape((a.shape[0], n, L) + a.shape[2:])
    return jnp.swapaxes(jnp.swapaxes(a, 0, 1), 2, 3)


def gated_delta_rule(q, k, v, g_log, beta, s0):
    B, T, H, _ = q.shape
    dv = v.shape[-1]
    L = min(DN_CHUNK, T)
    n = -(-T // L)
    pad = n * L - T
    q, k, v = _to_chunks(q, n, L, pad), _to_chunks(k, n, L, pad), _to_chunks(v, n, L, pad)
    g_log, beta = _to_chunks(g_log, n, L, pad), _to_chunks(beta, n, L, pad)
    G = jnp.cumsum(g_log, axis=-1)
    causal = jnp.tril(jnp.ones((L, L), dtype=bool))
    strict = jnp.tril(jnp.ones((L, L), dtype=bool), -1)
    diff = G[..., :, None] - G[..., None, :]
    decay = jnp.where(causal, jnp.exp(jnp.where(causal, diff, 0.0)), 0.0)
    kb = k * beta[..., None]
    a_mat = jnp.where(strict, jnp.einsum('nbhid,nbhjd->nbhij', kb, k) * decay, 0.0)
    eye = jnp.eye(L, dtype=q.dtype)
    t_inv = lax.linalg.triangular_solve(eye + a_mat, jnp.broadcast_to(eye, a_mat.shape),
                                        left_side=True, lower=True, unit_diagonal=True)
    u_vals = jnp.einsum('nbhij,nbhjv->nbhiv', t_inv, v * beta[..., None])
    w_vals = jnp.einsum('nbhij,nbhjd->nbhid', t_inv, kb * jnp.exp(G)[..., None])
    qk = jnp.where(causal, jnp.einsum('nbhid,nbhjd->nbhij', q, k) * decay, 0.0)

    def step(S, xs):
        q_c, k_c, u_c, w_c, g_c, qk_c = xs
        v_new = u_c - jnp.einsum('bhld,bhdv->bhlv', w_c, S)
        o = (jnp.einsum('bhld,bhdv->bhlv', q_c * jnp.exp(g_c)[..., None], S)
             + jnp.einsum('bhij,bhjv->bhiv', qk_c, v_new))
        g_last = g_c[..., -1:]
        S = (S * jnp.exp(g_last)[..., None]
             + jnp.einsum('bhld,bhlv->bhdv', k_c * jnp.exp(g_last - g_c)[..., None], v_new))
        return S, o

    s_final, o = lax.scan(step, s0, (q, k, u_vals, w_vals, G, qk))
    o = jnp.swapaxes(jnp.swapaxes(o, 2, 3), 0, 1).reshape(B, n * L, H, dv)[:, :T]
    return o, s_final


def token_mixing(h, conv_state, ssm_state, p):
    B, T, _ = h.shape
    proj = h @ p['w_in'] + p['b_in']
    offs = np.cumsum([GM_WIDTH, GM_WIDTH, 3 * DN_WIDTH, DN_WIDTH, DN_HEADS, DN_HEADS]).tolist()
    u, v, qkv, z, beta_logit, decay_logit, gates = jnp.split(proj, offs, axis=-1)

    u = jax.nn.gelu(u)
    v = layer_norm(jax.nn.gelu(v), p['gm_v_g'], p['gm_v_b'])
    y_a = u * chunk_spatial_mix(v, p['gm_w_s'], p['gm_b_s']).astype(u.dtype)

    xc = jnp.concatenate([conv_state.astype(qkv.dtype), qkv], axis=1)
    conv_new = xc[:, T:]
    w_c = p['dn_conv_w']
    acc = xc[:, 0:T] * w_c[0]
    for i in range(1, DN_CONV):
        acc = acc + xc[:, i:i + T] * w_c[i]
    qkv_c = jax.nn.silu(acc).astype(jnp.float32)
    q, k, vd = jnp.split(qkv_c, 3, axis=-1)
    q = l2_normalize(q.reshape(B, T, DN_HEADS, DN_HEAD_DIM)) * (DN_HEAD_DIM ** -0.5)
    k = l2_normalize(k.reshape(B, T, DN_HEADS, DN_HEAD_DIM))
    vd = vd.reshape(B, T, DN_HEADS, DN_HEAD_DIM)
    beta = jax.nn.sigmoid(beta_logit.astype(jnp.float32))
    g_log = (-jnp.exp(p['dn_a_log'].astype(jnp.float32))
             * jax.nn.softplus(decay_logit.astype(jnp.float32) + p['dn_dt_bias'].astype(jnp.float32)))
    o, ssm_new = gated_delta_rule(q, k, vd, g_log, beta, ssm_state.astype(jnp.float32))
    o = rms_norm(o, p['dn_norm_w']) * jax.nn.silu(z.astype(jnp.float32).reshape(B, T, DN_HEADS, DN_HEAD_DIM))
    y_b = o.reshape(B, T, DN_WIDTH).astype(h.dtype)

    gate_a, gate_b = jnp.split(gates, 2, axis=-1)
    merged = (jax.nn.sigmoid(gate_a) * (y_a @ p['w_branch_a'])
              + jax.nn.sigmoid(gate_b) * (y_b @ p['w_branch_b']))
    return merged @ p['w_out'], v, conv_new, ssm_new.astype(ssm_state.dtype)


def trunk_layer(x, conv_state, ssm_state, p):
    x = layer_norm(ALPHA * x + 0.5 * swiglu_ffn(x, p['ffn1_w_up'], p['ffn1_w_down']), p['ln1_g'], p['ln1_b'])
    mix, v_rows, conv_new, ssm_new = token_mixing(x, conv_state, ssm_state, p)
    x = layer_norm(ALPHA * x + mix, p['ln2_g'], p['ln2_b'])
    x = layer_norm(ALPHA * x + 0.5 * swiglu_ffn(x, p['ffn2_w_up'], p['ffn2_w_down']), p['ln3_g'], p['ln3_b'])
    return x, v_rows, conv_new, ssm_new


def setup_inputs(seed: int = 0) -> dict:
    key = jax.random.key(seed)
    ks = jax.random.split(key, 32)
    f32 = jnp.float32

    def nrm(k, shape, scale):
        return jax.random.normal(k, shape, f32) * scale

    def gain(k, n):
        return 1.0 + 0.02 * jax.random.normal(k, (DEPTH, n), f32)

    def bias(k, n):
        return 0.02 * jax.random.normal(k, (DEPTH, n), f32)

    dt = jnp.exp(jax.random.uniform(ks[17], (DEPTH, DN_HEADS), f32, math.log(1e-3), math.log(1e-1)))
    return {
        'x_prompt': nrm(ks[0], (BATCH, SEQ, D_MODEL), 1.0),
        'x_sample': nrm(ks[1], (DEC_BATCH, DEC_SEQ, D_MODEL), 1.0),
        'state_conv': nrm(ks[2], (DEPTH, DEC_BATCH, DN_CONV - 1, 3 * DN_WIDTH), 1.0),
        'state_ssm': nrm(ks[3], (DEPTH, DEC_BATCH, DN_HEADS, DN_HEAD_DIM, DN_HEAD_DIM), 0.1),
        'ffn1_w_up': nrm(ks[4], (DEPTH, D_MODEL, 2 * D_FF), D_MODEL ** -0.5),
        'ffn1_w_down': nrm(ks[5], (DEPTH, D_FF, D_MODEL), BETA_INIT * D_FF ** -0.5),
        'ln1_g': gain(ks[6], D_MODEL),
        'ln1_b': bias(ks[7], D_MODEL),
        'w_in': nrm(ks[8], (DEPTH, D_MODEL, IN_COLS), D_MODEL ** -0.5),
        'b_in': bias(ks[9], IN_COLS),
        'gm_v_g': gain(ks[10], GM_WIDTH),
        'gm_v_b': bias(ks[11], GM_WIDTH),
        'gm_w_s': nrm(ks[12], (DEPTH, GM_GROUPS, GM_CHUNK, GM_CHUNK), GM_CHUNK ** -0.5),
        'gm_b_s': 1.0 + 0.02 * jax.random.normal(ks[13], (DEPTH, GM_GROUPS, GM_CHUNK), f32),
        'dn_conv_w': nrm(ks[14], (DEPTH, DN_CONV, 3 * DN_WIDTH), DN_CONV ** -0.5),
        'dn_a_log': jnp.log(jax.random.uniform(ks[15], (DEPTH, DN_HEADS), f32, 1.0, 16.0)),
        'dn_dt_bias': dt + jnp.log(-jnp.expm1(-dt)),
        'dn_norm_w': gain(ks[16], DN_HEAD_DIM),
        'w_branch_a': nrm(ks[18], (DEPTH, GM_WIDTH, D_MODEL), GM_WIDTH ** -0.5),
        'w_branch_b': nrm(ks[19], (DEPTH, DN_WIDTH, D_MODEL), DN_WIDTH ** -0.5),
        'w_out': nrm(ks[20], (DEPTH, D_MODEL, D_MODEL), BETA_INIT * D_MODEL ** -0.5),
        'ln2_g': gain(ks[21], D_MODEL),
        'ln2_b': bias(ks[22], D_MODEL),
        'ffn2_w_up': nrm(ks[23], (DEPTH, D_MODEL, 2 * D_FF), D_MODEL ** -0.5),
        'ffn2_w_down': nrm(ks[24], (DEPTH, D_FF, D_MODEL), BETA_INIT * D_FF ** -0.5),
        'ln3_g': gain(ks[25], D_MODEL),
        'ln3_b': bias(ks[26], D_MODEL),
    }


def reference(x_prompt, x_sample, state_conv, state_ssm, ffn1_w_up, ffn1_w_down, ln1_g, ln1_b,
              w_in, b_in, gm_v_g, gm_v_b, gm_w_s, gm_b_s, dn_conv_w, dn_a_log, dn_dt_bias, dn_norm_w,
              w_branch_a, w_branch_b, w_out, ln2_g, ln2_b, ffn2_w_up, ffn2_w_down, ln3_g, ln3_b):
    y_p, y_s = x_prompt, x_sample
    conv_p, ssm_p, conv_s, ssm_s, v_s = [], [], [], [], []
    for l in range(DEPTH):
        p = {
            'ffn1_w_up': ffn1_w_up[l], 'ffn1_w_down': ffn1_w_down[l], 'ln1_g': ln1_g[l], 'ln1_b': ln1_b[l],
            'w_in': w_in[l], 'b_in': b_in[l], 'gm_v_g': gm_v_g[l], 'gm_v_b': gm_v_b[l],
            'gm_w_s': gm_w_s[l], 'gm_b_s': gm_b_s[l], 'dn_conv_w': dn_conv_w[l], 'dn_a_log': dn_a_log[l],
            'dn_dt_bias': dn_dt_bias[l], 'dn_norm_w': dn_norm_w[l], 'w_branch_a': w_branch_a[l],
            'w_branch_b': w_branch_b[l], 'w_out': w_out[l], 'ln2_g': ln2_g[l], 'ln2_b': ln2_b[l],
            'ffn2_w_up': ffn2_w_up[l], 'ffn2_w_down': ffn2_w_down[l], 'ln3_g': ln3_g[l], 'ln3_b': ln3_b[l],
        }
        zero_conv = jnp.zeros((x_prompt.shape[0], DN_CONV - 1, 3 * DN_WIDTH), x_prompt.dtype)
        zero_ssm = jnp.zeros((x_prompt.shape[0], DN_HEADS, DN_HEAD_DIM, DN_HEAD_DIM), state_ssm.dtype)
        y_p, _, c_p, s_p = trunk_layer(y_p, zero_conv, zero_ssm, p)
        y_s, v_rows, c_s, s_s = trunk_layer(y_s, state_conv[l], state_ssm[l], p)
        conv_p.append(c_p)
        ssm_p.append(s_p)
        conv_s.append(c_s)
        ssm_s.append(s_s)
        v_s.append(v_rows)
    return (y_p, y_s, jnp.stack(conv_p), jnp.stack(ssm_p), jnp.stack(conv_s), jnp.stack(ssm_s), jnp.stack(v_s))
```

```cpp
#define MK_ONE_LAUNCH 0
#include <hip/hip_runtime.h>
#include <hip/hip_cooperative_groups.h>
#include <cstdio>
namespace cg = cooperative_groups;
namespace pg8 {
#define PG8_LAS __attribute__((address_space(3)))
typedef unsigned short bf16_t;
typedef short bf16x8 __attribute__((ext_vector_type(8)));
typedef float f32x4 __attribute__((ext_vector_type(4)));
typedef unsigned u32x4 __attribute__((ext_vector_type(4)));
constexpr int BM = 256, BK = 64, HALF = 128, HTB = HALF * BK * 2  , STAGE_BYTES = 8 * HTB, NXCD = 8, WGM = 8;

__host__ __device__ __forceinline__ int lds_byte(int r, int c) { const int st = (r >> 4) * 2 + (c >> 5), rr = r & 15, cc = c & 31, ob = rr * 64 + cc * 2; return st * 1024 + (ob ^ (((ob >> 9) & 1) << 5)); }
__host__ __device__ __forceinline__ void stage_rc(int b, int& R, int& C) { const int st = b / 1024, sb = b % 1024, swz = sb ^ (((sb >> 9) & 1) << 5); R = (st >> 1) * 16 + swz / 64; C = (st & 1) * 32 + (swz % 64) / 2; }
__host__ __device__ __forceinline__ int perm32(int rho) { const int n = rho >> 4, i = rho & 15; return 8 * (i >> 2) + 4 * n + (i & 3); }
struct Unit { int pm, pn; };
struct Gemm { const bf16_t* A; const bf16_t* Bt; int M, N, K; };
struct StaticOrder {
    int nM, nN, nwg, G, c;
    __host__ __device__ void init(int M, int N, int G_, int c_) { nM = M / BM; nN = N / BM; nwg = nM * nN; G = G_; c = c_; }
    __host__ __device__ bool next(int i, Unit& u) const {
        const long L = (long)i * G + c; if (L >= nwg) return false;
        int wgid = (int)L; { const int q = nwg / NXCD, r = nwg % NXCD, xcd = wgid % NXCD, off = wgid / NXCD; wgid = (xcd < r ? xcd * (q + 1) : r * (q + 1) + (xcd - r) * q) + off; }
        const int nig = WGM * nN, gid = wgid / nig, fm = gid * WGM, gsz = (nM - fm) < WGM ? (nM - fm) : WGM;
        u.pm = fm + ((wgid % nig) % gsz); u.pn = (wgid % nig) / gsz; return true;
    }
    __device__ __forceinline__ void a_ready(const Unit&) const {}
    __device__ __forceinline__ void done(const Unit&) const {}
};
__device__ __forceinline__ unsigned cvt_pk_bf16(float lo, float hi) { unsigned r; asm volatile("v_cvt_pk_bf16_f32 %0, %1, %2" : "=v"(r) : "v"(lo), "v"(hi)); return r; }
template <class Epi, class Sched>
__device__ __forceinline__ void gemm_phase(PG8_LAS unsigned char* lds, const Gemm g, const Sched& S, const Epi& E) {
    const int tid = threadIdx.x, wid = __builtin_amdgcn_readfirstlane(tid >> 6), lane = tid & 63, wr = wid >> 2, wc = wid & 3, fr = lane & 15, fq = lane >> 4;
    const int K = g.K, nt = K / BK;
    unsigned voffA[2], voffB[2];
#pragma unroll
    for (int i = 0; i < 2; ++i) { int R, C; stage_rc(tid * 16 + i * 8192, R, C); const int Rb = Epi::PERM ? ((R & ~31) + perm32(R & 31)) : R;
        voffA[i] = (unsigned)(R * K + C) * 2u; voffB[i] = (unsigned)(Rb * K + C) * 2u; }
    const size_t kstep = (size_t)(BK * 2);
    const size_t hstep = (size_t)HALF * K * 2;
    const size_t tstep = 2 * hstep;
    const unsigned ldsw = (unsigned)wid * 1024u;
    const int aoff = lds_byte(wr * 64 + fr, fq * 8), boff = lds_byte(wc * 32 + fr, fq * 8);
#define PG8_SA(b, h) (((b) * 2 + (h)) * HTB)
#define PG8_SB(b, h) ((4 + (b) * 2 + (h)) * HTB)
#define PG8_STAGE(bufoff, gbase, voff) do { _Pragma("unroll") for (int _i = 0; _i < 2; ++_i) \
        __builtin_amdgcn_global_load_lds((const unsigned*)((const char*)(gbase) + (voff)[_i]), (PG8_LAS unsigned*)(lds + (bufoff) + ldsw + _i * 8192), 16, 0, 0); } while (0)
#define PG8_LDA(dst, b, h) do { _Pragma("unroll") for (int m = 0; m < 4; ++m) _Pragma("unroll") for (int k = 0; k < 2; ++k) dst[m][k] = *(const PG8_LAS bf16x8*)(lds + PG8_SA(b, h) + aoff + m * 2048 + k * 1024); } while (0)
#define PG8_LDB(dst, b, h) do { _Pragma("unroll") for (int n = 0; n < 2; ++n) _Pragma("unroll") for (int k = 0; k < 2; ++k) dst[n][k] = *(const PG8_LAS bf16x8*)(lds + PG8_SB(b, h) + boff + n * 2048 + k * 1024); } while (0)
#define PG8_MMA(ai, bj, At, Bt) do { __builtin_amdgcn_s_setprio(1); _Pragma("unroll") for (int m = 0; m < 4; ++m) _Pragma("unroll") for (int n = 0; n < 2; ++n) _Pragma("unroll") for (int k = 0; k < 2; ++k) \
        acc[ai][bj][m][n] = __builtin_amdgcn_mfma_f32_16x16x32_bf16(Bt[n][k], At[m][k], acc[ai][bj][m][n], 0, 0, 0); __builtin_amdgcn_s_setprio(0); } while (0)
#define PG8_WAIT_V(n) asm volatile("s_waitcnt vmcnt(" #n ")" ::: "memory")
#define PG8_WAIT_L(n) asm volatile("s_waitcnt lgkmcnt(" #n ")" ::: "memory")
#define PG8_BAR __builtin_amdgcn_s_barrier()
#define PG8_SCHED __builtin_amdgcn_sched_barrier(0)
    Unit cur, nxt; int ui = 0;
    if (!S.next(0, cur)) return;
    f32x4 acc[2][2][4][2];
#pragma unroll
    for (int a = 0; a < 2; ++a)
#pragma unroll
        for (int b = 0; b < 2; ++b)
#pragma unroll
            for (int m = 0; m < 4; ++m)
#pragma unroll
                for (int n = 0; n < 2; ++n) acc[a][b][m][n] = (f32x4){0.f, 0.f, 0.f, 0.f};
    bf16x8 At[4][2], B0[2][2], B1[2][2];
    const char* cA = (const char*)g.A + (size_t)cur.pm * tstep; const char* cB = (const char*)g.Bt + (size_t)cur.pn * tstep;
    S.a_ready(cur);
    PG8_STAGE(PG8_SB(0, 0), cB, voffB); PG8_STAGE(PG8_SA(0, 0), cA, voffA); PG8_STAGE(PG8_SB(0, 1), cB + hstep, voffB); PG8_STAGE(PG8_SA(0, 1), cA + hstep, voffA);
    if (wr == 1) PG8_BAR;
    PG8_WAIT_V(4); PG8_BAR;
    PG8_STAGE(PG8_SB(1, 0), cB + kstep, voffB); PG8_STAGE(PG8_SA(1, 0), cA + kstep, voffA); PG8_STAGE(PG8_SB(1, 1), cB + hstep + kstep, voffB);
    PG8_WAIT_V(6); PG8_BAR;
    for (;;) {
        const bool has_next = S.next(ui + 1, nxt);
        const char* nA = has_next ? (const char*)g.A + (size_t)nxt.pm * tstep : cA; const char* nB = has_next ? (const char*)g.Bt + (size_t)nxt.pn * tstep : cB;
        for (int t = 0; t < nt; t += 2) {
            const bool last = (t == nt - 2);
            const char* a1 = cA + (size_t)(t + 1) * kstep;
            const char* a2 = last ? nA : cA + (size_t)(t + 2) * kstep; const char* b2 = last ? nB : cB + (size_t)(t + 2) * kstep;
            const char* a3 = a2 + kstep; const char* b3 = b2 + kstep;
            if (last && has_next) S.a_ready(nxt);
            PG8_LDB(B0, 0, 0); PG8_SCHED; PG8_LDA(At, 0, 0); PG8_STAGE(PG8_SA(1, 1), a1 + hstep, voffA);
            PG8_WAIT_L(8); PG8_BAR; PG8_WAIT_L(0); PG8_MMA(0, 0, At, B0); PG8_BAR; PG8_SCHED;
            PG8_LDB(B1, 0, 1); PG8_STAGE(PG8_SB(0, 0), b2, voffB);
            PG8_BAR; PG8_WAIT_L(0); PG8_MMA(0, 1, At, B1); PG8_BAR;
            PG8_LDA(At, 0, 1); PG8_STAGE(PG8_SA(0, 0), a2, voffA);
            PG8_BAR; PG8_WAIT_L(0); PG8_MMA(1, 0, At, B0); PG8_BAR; PG8_SCHED;
            PG8_STAGE(PG8_SB(0, 1), b2 + hstep, voffB);
            PG8_WAIT_V(6); PG8_BAR; PG8_MMA(1, 1, At, B1); PG8_BAR;
            PG8_LDB(B0, 1, 0); PG8_SCHED; PG8_LDA(At, 1, 0); PG8_STAGE(PG8_SA(0, 1), a2 + hstep, voffA);
            PG8_WAIT_L(8); PG8_BAR; PG8_WAIT_L(0); PG8_MMA(0, 0, At, B0); PG8_BAR; PG8_SCHED;
            PG8_LDB(B1, 1, 1); PG8_STAGE(PG8_SB(1, 0), b3, voffB);
            PG8_BAR; PG8_WAIT_L(0); PG8_MMA(0, 1, At, B1); PG8_BAR;
            PG8_LDA(At, 1, 1); PG8_STAGE(PG8_SA(1, 0), a3, voffA);
            PG8_BAR; PG8_WAIT_L(0); PG8_MMA(1, 0, At, B0); PG8_BAR; PG8_SCHED;
            PG8_STAGE(PG8_SB(1, 1), b3 + hstep, voffB);
            PG8_WAIT_V(6); PG8_BAR; PG8_MMA(1, 1, At, B1); PG8_BAR;
        }
        if constexpr (!Epi::AFTER_DRAIN) { E(acc, cur, wr, wc, fr, fq); S.done(cur); }
        if (!has_next) break;
#pragma unroll
        for (int a = 0; a < 2; ++a)
#pragma unroll
            for (int b = 0; b < 2; ++b)
#pragma unroll
                for (int m = 0; m < 4; ++m)
#pragma unroll
                    for (int n = 0; n < 2; ++n) acc[a][b][m][n] = (f32x4){0.f, 0.f, 0.f, 0.f};
        cur = nxt; cA = nA; cB = nB; ++ui;
    }
    PG8_WAIT_V(0);
    if (wr == 0) PG8_BAR;
    PG8_BAR;
    if constexpr (Epi::AFTER_DRAIN) { E.fused(acc, cur, wr, wc, fr, fq, lds, wid, lane); S.done(cur); }
#undef PG8_SA
#undef PG8_SB
#undef PG8_STAGE
#undef PG8_LDA
#undef PG8_LDB
#undef PG8_MMA
#undef PG8_WAIT_V
#undef PG8_WAIT_L
#undef PG8_BAR
#undef PG8_SCHED
}
}
using pg8::bf16_t; using pg8::bf16x8; using pg8::f32x4; using pg8::u32x4;
#define LAS __attribute__((address_space(3)))
typedef float f32x16 __attribute__((ext_vector_type(16)));
typedef unsigned u32x2 __attribute__((ext_vector_type(2)));
#define DI __device__ __forceinline__

constexpr int DM = 1024, MP = 16384, MS = 512, MT = MP + MS, SEQ = 2048, DFF = 2816, NIN = 8448, NQKV = 3072;
constexpr float ALPHA = 1.189207115002721f;
constexpr size_t O_Y = 0, O_CONVP = (size_t)MT * DM, O_SSMP = O_CONVP + 8 * 3 * 3072, O_CONVS = O_SSMP + (size_t)8 * 8 * 128 * 128,
                 O_SSMS = O_CONVS + (size_t)128 * 3 * 3072, O_GMV = O_SSMS + (size_t)128 * 8 * 128 * 128, O_END = O_GMV + (size_t)MS * DM;
constexpr size_t W_UP1 = 0, W_DN1 = W_UP1 + (size_t)2 * DFF * DM * 2, W_IN = W_DN1 + (size_t)DM * DFF * 2, W_BA = W_IN + (size_t)NIN * DM * 2,
                 W_BB = W_BA + (size_t)DM * DM * 2, W_WO = W_BB + (size_t)DM * DM * 2, W_UP2 = W_WO + (size_t)DM * DM * 2, W_DN2 = W_UP2 + (size_t)2 * DFF * DM * 2,
                 W_BIN = W_DN2 + (size_t)DM * DFF * 2, W_BETA = W_BIN + (size_t)NIN * 4, W_GLOG = W_BETA + (size_t)MT * 8 * 4, W_XB = W_GLOG + (size_t)MT * 8 * 4,
                 W_U = W_XB + (size_t)MT * DM * 2, W_Z = W_U + (size_t)MT * DM * 2, W_Q = W_Z + (size_t)MT * DM * 2, W_M1 = W_Q + (size_t)MT * DM * 2,
                 W_END = W_Q + (size_t)MT * NQKV * 2;
constexpr int LDS_BYTES = pg8::STAGE_BYTES;

struct Args {
    const float *x_p, *x_s, *st_conv, *st_ssm, *up1, *dn1, *ln1g, *ln1b, *w_in, *b_in, *gmvg, *gmvb, *gmws, *gmbs, *convw, *alog, *dtb, *dnw, *wba, *wbb, *wo, *ln2g, *ln2b, *up2, *dn2, *ln3g, *ln3b;
    float* out; unsigned char* ws; int ph_lo, ph_hi;
};

DI bf16_t f2bf(float x) { unsigned u = __float_as_uint(x); u += 0x7fffu + ((u >> 16) & 1u); return (bf16_t)(u >> 16); }
DI float bf2f(bf16_t b) { return __uint_as_float(((unsigned)b) << 16); }
DI float bflo(unsigned w) { return __uint_as_float(w << 16); }
DI float bfhi(unsigned w) { return __uint_as_float(w & 0xffff0000u); }
DI unsigned pk2(float lo, float hi) { return (unsigned)f2bf(lo) | ((unsigned)f2bf(hi) << 16); }
DI float sigmoidf_(float x) { return 1.0f / (1.0f + __expf(-x)); }
DI float siluf_(float x) { return x / (1.0f + __expf(-x)); }
DI float gelu_tanh(float x) { const float u = 0.7978845608028654f * (x + 0.044715f * x * x * x); return x / (1.0f + __expf(-2.0f * u)); }
DI float softplusf_(float x) { return fmaxf(x, 0.f) + log1pf(__expf(-fabsf(x))); }
DI float wave_sum(float v) {
#pragma unroll
    for (int o = 32; o > 0; o >>= 1) v += __shfl_xor(v, o, 64);
    return v;
}

DI int src_col16(int mode, int n16) {
    if (mode == 0) return n16;
    if (mode == 1) { const int grp = n16 >> 5, half = (n16 >> 4) & 1; return half * DFF + grp * 16; }
    if (n16 < 6144) return n16;
    if (n16 < 8192) return n16 + 16;
    if (n16 < 8208) return n16 - 8192 + 6144;
    return -1;
}
DI void convert_weight(const float* __restrict__ src, int K, int ld, bf16_t* __restrict__ dst, int Nd, int mode, LAS bf16_t* tile) {
    const int tid = threadIdx.x, tk = K / 64, ntiles = (Nd / 64) * tk;
    for (int t = blockIdx.x; t < ntiles; t += gridDim.x) {
        const int n0 = (t / tk) * 64, k0 = (t % tk) * 64;
        { const int krow = tid >> 3, cseg = tid & 7; const int sc = src_col16(mode, n0 + (cseg >> 1) * 16);
          f32x4 a = {0.f, 0.f, 0.f, 0.f}, b = a;
          if (sc >= 0) { const float* p = src + (size_t)(k0 + krow) * ld + sc + (cseg & 1) * 8; a = *(const f32x4*)p; b = *(const f32x4*)(p + 4); }
#pragma unroll
          for (int i = 0; i < 4; ++i) { tile[(cseg * 8 + i) * 72 + krow] = f2bf(a[i]); tile[(cseg * 8 + 4 + i) * 72 + krow] = f2bf(b[i]); } }
        __syncthreads();
        { const int nl = tid >> 3, ks = tid & 7; const u32x4 v = *(const LAS u32x4*)(tile + nl * 72 + ks * 8);
          *(u32x4*)(dst + (size_t)(n0 + nl) * K + k0 + ks * 8) = v; }
        __syncthreads();
    }
}
DI void phase_convert(const Args& a, LAS unsigned char* lds) {
    LAS bf16_t* tile = (LAS bf16_t*)lds;
    unsigned char* ws = a.ws;
    convert_weight(a.up1, DM, 2 * DFF, (bf16_t*)(ws + W_UP1), 2 * DFF, 1, tile);
    convert_weight(a.dn1, DFF, DM, (bf16_t*)(ws + W_DN1), DM, 0, tile);
    convert_weight(a.w_in, DM, 8208, (bf16_t*)(ws + W_IN), NIN, 2, tile);
    convert_weight(a.wba, DM, DM, (bf16_t*)(ws + W_BA), DM, 0, tile);
    convert_weight(a.wbb, DM, DM, (bf16_t*)(ws + W_BB), DM, 0, tile);
    convert_weight(a.wo, DM, DM, (bf16_t*)(ws + W_WO), DM, 0, tile);
    convert_weight(a.up2, DM, 2 * DFF, (bf16_t*)(ws + W_UP2), 2 * DFF, 1, tile);
    convert_weight(a.dn2, DFF, DM, (bf16_t*)(ws + W_DN2), DM, 0, tile);
    const size_t gt = (size_t)blockIdx.x * blockDim.x + threadIdx.x, gn = (size_t)gridDim.x * blockDim.x;
    float* binr = (float*)(ws + W_BIN);
    for (size_t i = gt; i < (size_t)NIN; i += gn) { const int sc = src_col16(2, (int)i & ~15); binr[i] = sc >= 0 ? a.b_in[sc + ((int)i & 15)] : 0.f; }
    bf16_t* xb = (bf16_t*)(ws + W_XB);
    for (size_t i = gt; i < (size_t)MT * DM / 8; i += gn) {
        const size_t e = i * 8; const float* p = e < (size_t)MP * DM ? a.x_p + e : a.x_s + (e - (size_t)MP * DM);
        const f32x4 v0 = *(const f32x4*)p, v1 = *(const f32x4*)(p + 4);
        u32x4 w; w.x = pk2(v0[0], v0[1]); w.y = pk2(v0[2], v0[3]); w.z = pk2(v1[0], v1[1]); w.w = pk2(v1[2], v1[3]);
        *(u32x4*)(xb + e) = w;
    }
}

struct EpiSwiglu {
    static constexpr bool PERM = false, AFTER_DRAIN = false;
    bf16_t* H;
    DI void operator()(const f32x4 (&acc)[2][2][4][2], const pg8::Unit& u, int wr, int wc, int fr, int fq) const {
        const int row0 = u.pm * 256 + wr * 64 + fr, h0 = u.pn * 128 + wc * 16 + 4 * fq;
#pragma unroll
        for (int ai = 0; ai < 2; ++ai)
#pragma unroll
            for (int m = 0; m < 4; ++m) { bf16_t* rowp = H + (size_t)(row0 + ai * 128 + m * 16) * DFF + h0;
#pragma unroll
                for (int bj = 0; bj < 2; ++bj) { const f32x4 x = acc[ai][bj][m][0], g = acc[ai][bj][m][1];
                    u32x2 w; w.x = pg8::cvt_pk_bf16(siluf_(x[0]) * g[0], siluf_(x[1]) * g[1]); w.y = pg8::cvt_pk_bf16(siluf_(x[2]) * g[2], siluf_(x[3]) * g[3]);
                    *(u32x2*)(rowp + bj * 64) = w; } }
    }
};
template <int RES  > struct EpiRes {
    static constexpr bool PERM = false, AFTER_DRAIN = false;
    float* R; const float* xp; const float* xs; const bf16_t* xb; float scale;
    DI void operator()(const f32x4 (&acc)[2][2][4][2], const pg8::Unit& u, int wr, int wc, int fr, int fq) const {
        const int row0 = u.pm * 256 + wr * 64 + fr, col0 = u.pn * 256 + wc * 32 + 4 * fq;
#pragma unroll
        for (int ai = 0; ai < 2; ++ai)
#pragma unroll
            for (int m = 0; m < 4; ++m) { const int row = row0 + ai * 128 + m * 16;
#pragma unroll
                for (int bj = 0; bj < 2; ++bj)
#pragma unroll
                    for (int n = 0; n < 2; ++n) { const int col = col0 + bj * 128 + n * 16; f32x4 r;
                        if (RES == 0) { const float* p = row < MP ? xp + (size_t)row * DM + col : xs + (size_t)(row - MP) * DM + col; r = *(const f32x4*)p; }
                        else { const u32x2 w = *(const u32x2*)(xb + (size_t)row * DM + col); r = (f32x4){bflo(w.x), bfhi(w.x), bflo(w.y), bfhi(w.y)}; }
                        *(f32x4*)(R + (size_t)row * DM + col) = r * ALPHA + acc[ai][bj][m][n] * scale; } }
    }
};
struct EpiProj {
    static constexpr bool PERM = true, AFTER_DRAIN = false;
    bf16_t *U, *V, *QKV, *Z, *G; float *beta, *glog, *convp, *convs; const float *bias, *alog, *dtb;
    template <int MODE> DI void body(const f32x4 (&acc)[2][2][4][2], int pn, int row0, int wc, int fq) const {
#pragma unroll
        for (int bj = 0; bj < 2; ++bj) {
            const int col = pn * 256 + wc * 32 + 8 * fq + bj * 128;
            const f32x4 b0 = *(const f32x4*)(bias + col), b1 = *(const f32x4*)(bias + col + 4);
#pragma unroll
            for (int ai = 0; ai < 2; ++ai)
#pragma unroll
                for (int m = 0; m < 4; ++m) {
                    const int row = row0 + ai * 128 + m * 16;
                    f32x4 v0 = acc[ai][bj][m][0] + b0, v1 = acc[ai][bj][m][1] + b1;
                    if (MODE == 5) {
                        const int c = col - 8192;
                        if (c == 0) { f32x4 o0, o1;
#pragma unroll
                            for (int j = 0; j < 4; ++j) { o0[j] = sigmoidf_(v0[j]); o1[j] = sigmoidf_(v1[j]); }
                            *(f32x4*)(beta + (size_t)row * 8) = o0; *(f32x4*)(beta + (size_t)row * 8 + 4) = o1; }
                        if (c == 8) { f32x4 o0, o1;
#pragma unroll
                            for (int j = 0; j < 4; ++j) { o0[j] = -__expf(alog[j]) * softplusf_(v0[j] + dtb[j]); o1[j] = -__expf(alog[4 + j]) * softplusf_(v1[j] + dtb[4 + j]); }
                            *(f32x4*)(glog + (size_t)row * 8) = o0; *(f32x4*)(glog + (size_t)row * 8 + 4) = o1; }
                    } else {
                        bf16_t* dst;
                        if (MODE == 0 || MODE == 1) {
#pragma unroll
                            for (int j = 0; j < 4; ++j) { v0[j] = gelu_tanh(v0[j]); v1[j] = gelu_tanh(v1[j]); }
                            dst = (MODE == 0 ? U + (size_t)row * DM + col : V + (size_t)row * DM + (col - 1024));
                        } else if (MODE == 2) {
                            const int c = col - 2048; dst = QKV + (size_t)row * NQKV + c;
                            float* cp = nullptr;
                            if (row < MP) { const int t = row & (SEQ - 1); if (t >= SEQ - 3) cp = convp + ((size_t)(row >> 11) * 3 + (t - (SEQ - 3))) * NQKV + c; }
                            else { const int r = row - MP, t = r & 3; if (t >= 1) cp = convs + ((size_t)(r >> 2) * 3 + (t - 1)) * NQKV + c; }
                            if (cp) { *(f32x4*)cp = v0; *(f32x4*)(cp + 4) = v1; }
                        } else if (MODE == 3) {
#pragma unroll
                            for (int j = 0; j < 4; ++j) { v0[j] = siluf_(v0[j]); v1[j] = siluf_(v1[j]); }
                            dst = Z + (size_t)row * DM + (col - 5120);
                        } else {
#pragma unroll
                            for (int j = 0; j < 4; ++j) { v0[j] = sigmoidf_(v0[j]); v1[j] = sigmoidf_(v1[j]); }
                            dst = G + (size_t)row * 2048 + (col - 6144);
                        }
                        u32x4 w; w.x = pg8::cvt_pk_bf16(v0[0], v0[1]); w.y = pg8::cvt_pk_bf16(v0[2], v0[3]); w.z = pg8::cvt_pk_bf16(v1[0], v1[1]); w.w = pg8::cvt_pk_bf16(v1[2], v1[3]);
                        *(u32x4*)dst = w;
                    }
                }
        }
    }
    DI void operator()(const f32x4 (&acc)[2][2][4][2], const pg8::Unit& u, int wr, int wc, int fr, int fq) const {
        const int row0 = u.pm * 256 + wr * 64 + fr, pn = u.pn;
        if (pn < 4) body<0>(acc, pn, row0, wc, fq);
        else if (pn < 8) body<1>(acc, pn, row0, wc, fq);
        else if (pn < 20) body<2>(acc, pn, row0, wc, fq);
        else if (pn < 24) body<3>(acc, pn, row0, wc, fq);
        else if (pn < 32) body<4>(acc, pn, row0, wc, fq);
        else body<5>(acc, pn, row0, wc, fq);
    }
};
struct EpiM1 {
    static constexpr bool PERM = false, AFTER_DRAIN = false;
    float* M1; const bf16_t* G;
    DI void operator()(const f32x4 (&acc)[2][2][4][2], const pg8::Unit& u, int wr, int wc, int fr, int fq) const {
        const int row0 = u.pm * 256 + wr * 64 + fr, col0 = u.pn * 256 + wc * 32 + 4 * fq;
#pragma unroll
        for (int ai = 0; ai < 2; ++ai)
#pragma unroll
            for (int m = 0; m < 4; ++m) { const int row = row0 + ai * 128 + m * 16;
#pragma unroll
                for (int bj = 0; bj < 2; ++bj)
#pragma unroll
                    for (int n = 0; n < 2; ++n) { const int col = col0 + bj * 128 + n * 16;
                        const u32x2 w = *(const u32x2*)(G + (size_t)row * 2048 + col); const f32x4 gt = {bflo(w.x), bfhi(w.x), bflo(w.y), bfhi(w.y)};
                        *(f32x4*)(M1 + (size_t)row * DM + col) = gt * acc[ai][bj][m][n]; } asm volatile("" ::: "memory"); }
    }
};
struct EpiM2 {
    static constexpr bool PERM = false, AFTER_DRAIN = false;
    const float* M1; const bf16_t* G; bf16_t* Mm;
    DI void operator()(const f32x4 (&acc)[2][2][4][2], const pg8::Unit& u, int wr, int wc, int fr, int fq) const {
        const int row0 = u.pm * 256 + wr * 64 + fr, col0 = u.pn * 256 + wc * 32 + 4 * fq;
#pragma unroll
        for (int ai = 0; ai < 2; ++ai)
#pragma unroll
            for (int m = 0; m < 4; ++m) { const int row = row0 + ai * 128 + m * 16;
#pragma unroll
                for (int bj = 0; bj < 2; ++bj)
#pragma unroll
                    for (int n = 0; n < 2; ++n) { const int col = col0 + bj * 128 + n * 16;
                        const u32x2 w = *(const u32x2*)(G + (size_t)row * 2048 + 1024 + col); const f32x4 gt = {bflo(w.x), bfhi(w.x), bflo(w.y), bfhi(w.y)};
                        const f32x4 v = *(const f32x4*)(M1 + (size_t)row * DM + col) + gt * acc[ai][bj][m][n];
                        u32x2 o; o.x = pg8::cvt_pk_bf16(v[0], v[1]); o.y = pg8::cvt_pk_bf16(v[2], v[3]);
                        *(u32x2*)(Mm + (size_t)row * DM + col) = o; } asm volatile("" ::: "memory"); }
    }
};
template <class Epi> DI void run_gemm(LAS unsigned char* lds, const bf16_t* A, const bf16_t* Bt, int N, int K, const Epi& E) {
    pg8::Gemm g{A, Bt, MT, N, K}; pg8::StaticOrder S; S.init(MT, N, (int)gridDim.x, (int)blockIdx.x);
    pg8::gemm_phase<Epi, pg8::StaticOrder>(lds, g, S, E);
}

DI void phase_ln(float* __restrict__ R, const float* __restrict__ g, const float* __restrict__ b, bf16_t* __restrict__ xb) {
    const int lane = threadIdx.x & 63, wv = blockIdx.x * 8 + (threadIdx.x >> 6), nw = gridDim.x * 8;
    f32x4 gg[4], bb[4];
#pragma unroll
    for (int i = 0; i < 4; ++i) { gg[i] = *(const f32x4*)(g + 4 * lane + 256 * i); bb[i] = *(const f32x4*)(b + 4 * lane + 256 * i); }
    for (int row = wv; row < MT; row += nw) {
        float* p = R + (size_t)row * DM + 4 * lane; f32x4 v[4]; float s = 0.f;
#pragma unroll
        for (int i = 0; i < 4; ++i) { v[i] = *(const f32x4*)(p + 256 * i); s += v[i][0] + v[i][1] + v[i][2] + v[i][3]; }
        const float mu = wave_sum(s) * (1.0f / DM); float q = 0.f;
#pragma unroll
        for (int i = 0; i < 4; ++i) { v[i] -= mu; q += v[i][0] * v[i][0] + v[i][1] * v[i][1] + v[i][2] * v[i][2] + v[i][3] * v[i][3]; }
        const float rs = rsqrtf(wave_sum(q) * (1.0f / DM) + 1e-5f);
#pragma unroll
        for (int i = 0; i < 4; ++i) { const f32x4 y = v[i] * rs * gg[i] + bb[i];
            if (xb) { u32x2 w; w.x = pk2(y[0], y[1]); w.y = pk2(y[2], y[3]); *(u32x2*)(xb + (size_t)row * DM + 4 * lane + 256 * i) = w; }
            else *(f32x4*)(p + 256 * i) = y; }
    }
}
DI void phase_vnorm(bf16_t* __restrict__ V, const float* __restrict__ g, const float* __restrict__ b, float* __restrict__ gmv) {
    const int lane = threadIdx.x & 63, wv = blockIdx.x * 8 + (threadIdx.x >> 6), nw = gridDim.x * 8;
    for (int row = wv; row < MT; row += nw) {
        bf16_t* p = V + (size_t)row * DM + 8 * lane; float v[16]; float s = 0.f;
#pragma unroll
        for (int i = 0; i < 2; ++i) { const u32x4 w = *(const u32x4*)(p + 512 * i);
            v[8 * i + 0] = bflo(w.x); v[8 * i + 1] = bfhi(w.x); v[8 * i + 2] = bflo(w.y); v[8 * i + 3] = bfhi(w.y);
            v[8 * i + 4] = bflo(w.z); v[8 * i + 5] = bfhi(w.z); v[8 * i + 6] = bflo(w.w); v[8 * i + 7] = bfhi(w.w); }
#pragma unroll
        for (int i = 0; i < 16; ++i) s += v[i];
        const float mu = wave_sum(s) * (1.0f / DM); float q = 0.f;
#pragma unroll
        for (int i = 0; i < 16; ++i) { v[i] -= mu; q += v[i] * v[i]; }
        const float rs = rsqrtf(wave_sum(q) * (1.0f / DM) + 1e-5f);
#pragma unroll
        for (int i = 0; i < 2; ++i) { const int c = 8 * lane + 512 * i;
            const f32x4 g0 = *(const f32x4*)(g + c), g1 = *(const f32x4*)(g + c + 4), b0 = *(const f32x4*)(b + c), b1 = *(const f32x4*)(b + c + 4);
            f32x4 y0, y1;
#pragma unroll
            for (int j = 0; j < 4; ++j) { y0[j] = v[8 * i + j] * rs * g0[j] + b0[j]; y1[j] = v[8 * i + 4 + j] * rs * g1[j] + b1[j]; }
            u32x4 w; w.x = pk2(y0[0], y0[1]); w.y = pk2(y0[2], y0[3]); w.z = pk2(y1[0], y1[1]); w.w = pk2(y1[2], y1[3]);
            *(u32x4*)(p + 512 * i) = w;
            if (row >= MP) { float* o = gmv + (size_t)(row - MP) * DM + c; *(f32x4*)o = y0; *(f32x4*)(o + 4) = y1; } }
    }
}

DI int crow(int reg, int h) { return (reg & 3) + 8 * (reg >> 2) + 4 * h; }
DI void phase_mix(const Args& a, LAS unsigned char* lds) {
    bf16_t* U = (bf16_t*)(a.ws + W_U); const bf16_t* V = (const bf16_t*)(a.out + O_SSMS);
    LAS bf16_t* vt = (LAS bf16_t*)lds;
    const int tid = threadIdx.x, lane = tid & 63, wid = tid >> 6, r = lane & 31, h = lane >> 5, rb = wid >> 1, ch = wid & 1;
    for (int tile = blockIdx.x; tile < 1024; tile += gridDim.x) {
        const int g = tile & 7, bc = tile >> 3; const size_t tok0 = (size_t)bc * 128;
#pragma unroll
        for (int i = 0; i < 4; ++i) { const int e = tid + 512 * i, s = e >> 4, seg = e & 15;
            *(LAS u32x4*)(vt + s * 136 + seg * 8) = *(const u32x4*)(V + (tok0 + s) * DM + g * 128 + seg * 8); }
        __syncthreads();
        f32x16 acc[2];
#pragma unroll
        for (int i = 0; i < 16; ++i) { acc[0][i] = 0.f; acc[1][i] = 0.f; }
        const int t = 32 * rb + r; const float* wrow = a.gmws + ((size_t)g * 128 + t) * 128;
        for (int ks = 0; ks < 2 * rb + 2; ++ks) {
            const int s0 = 16 * ks + 8 * h;
            const f32x4 w0 = *(const f32x4*)(wrow + s0), w1 = *(const f32x4*)(wrow + s0 + 4);
            bf16x8 af;
#pragma unroll
            for (int j = 0; j < 4; ++j) { af[j] = (short)f2bf(s0 + j <= t ? w0[j] : 0.f); af[4 + j] = (short)f2bf(s0 + 4 + j <= t ? w1[j] : 0.f); }
#pragma unroll
            for (int nb = 0; nb < 2; ++nb) { bf16x8 bfr;
#pragma unroll
                for (int j = 0; j < 8; ++j) bfr[j] = (short)vt[(s0 + j) * 136 + 64 * ch + 32 * nb + r];
                acc[nb] = __builtin_amdgcn_mfma_f32_32x32x16_bf16(af, bfr, acc[nb], 0, 0, 0); }
        }
#pragma unroll
        for (int nb = 0; nb < 2; ++nb)
#pragma unroll
            for (int i = 0; i < 16; ++i) { const int tt = 32 * rb + crow(i, h), d = 64 * ch + 32 * nb + r;
                bf16_t* p = U + (tok0 + tt) * DM + g * 128 + d; *p = f2bf(bf2f(*p) * (acc[nb][i] + a.gmbs[g * 128 + tt])); }
        __syncthreads();
    }
    for (int e = blockIdx.x * 512 + tid; e < 128 * DM; e += gridDim.x * 512) {
        const int sq = e >> 10, c = e & 1023, g = c >> 7; const size_t base = ((size_t)MP + sq * 4) * DM + c;
        float v[4];
#pragma unroll
        for (int s = 0; s < 4; ++s) v[s] = bf2f(V[base + (size_t)s * DM]);
#pragma unroll
        for (int t = 0; t < 4; ++t) { float m = a.gmbs[g * 128 + t];
#pragma unroll
            for (int s = 0; s <= t; ++s) m += a.gmws[((size_t)g * 128 + t) * 128 + s] * v[s];
            bf16_t* p = U + base + (size_t)t * DM; *p = f2bf(bf2f(*p) * m); }
    }
}

DI void delta_seq_unit(const Args& a, LAS float* sm, int unit) {
    const int tid = threadIdx.x, j = tid & 127, qd = tid >> 7, lane = tid & 63, wid = tid >> 6;
    const bool prompt = unit < 64; const int uu = prompt ? unit : unit - 64, b = uu >> 3, h = uu & 7;
    const int T = prompt ? SEQ : 4; const size_t tok0 = prompt ? (size_t)b * SEQ : (size_t)MP + b * 4;
    const bf16_t* QKV = (const bf16_t*)(a.ws + W_Q); bf16_t* Z = (bf16_t*)(a.ws + W_Z);
    const float* betaA = (const float*)(a.ws + W_BETA); const float* glogA = (const float*)(a.ws + W_GLOG);
    float S[32];
    if (prompt) {
#pragma unroll
        for (int i = 0; i < 32; ++i) S[i] = 0.f;
    } else {
#pragma unroll
        for (int i = 0; i < 32; ++i) S[i] = a.st_ssm[(((size_t)b * 8 + h) * 128 + 32 * qd + i) * 128 + j];
    }
    const int part = tid >> 7, col = (part < 3 ? part : 0) * 1024 + h * 128 + j;
    float r0 = 0.f, r1 = 0.f, r2 = 0.f, cw0 = 0.f, cw1 = 0.f, cw2 = 0.f, cw3 = 0.f;
    if (tid < 384) { cw0 = a.convw[col]; cw1 = a.convw[3072 + col]; cw2 = a.convw[2 * 3072 + col]; cw3 = a.convw[3 * 3072 + col];
        if (!prompt) { r0 = a.st_conv[((size_t)b * 3 + 0) * 3072 + col]; r1 = a.st_conv[((size_t)b * 3 + 1) * 3072 + col]; r2 = a.st_conv[((size_t)b * 3 + 2) * 3072 + col]; } }
    const float dnw = a.dnw[j];
    const bf16_t* qp = QKV + tok0 * NQKV + col;
    float r3n = (tid < 384) ? bf2f(qp[0]) : 0.f;
    float betan = betaA[tok0 * 8 + h], gln = glogA[tok0 * 8 + h];
    float zn = (tid < 128) ? bf2f(Z[tok0 * DM + h * 128 + j]) : 0.f;
    for (int t = 0; t < T; ++t) {
        const size_t tok = tok0 + t;
        const float r3 = r3n, beta = betan, gl = gln, zc = zn;
        if (t + 1 < T) { if (tid < 384) r3n = bf2f(qp[(size_t)(t + 1) * NQKV]); betan = betaA[(tok + 1) * 8 + h]; gln = glogA[(tok + 1) * 8 + h]; if (tid < 128) zn = bf2f(Z[(tok + 1) * DM + h * 128 + j]); }
        if (tid < 384) {
            const float acc = r0 * cw0 + r1 * cw1 + r2 * cw2 + r3 * cw3; r0 = r1; r1 = r2; r2 = r3;
            const float val = siluf_(acc); sm[tid] = val;
            const float ss = wave_sum(val * val); if (lane == 0) sm[384 + wid] = ss;
        }
        __syncthreads();
        const float nq = rsqrtf(sm[384] + sm[385] + 1e-6f) * 0.08838834764831845f, nk = rsqrtf(sm[386] + sm[387] + 1e-6f);
        const float g = __expf(gl);
        float d = 0.f;
#pragma unroll
        for (int i = 0; i < 32; ++i) d += S[i] * sm[128 + 32 * qd + i];
        sm[400 + qd * 128 + j] = d * nk;
        __syncthreads();
        const float dt = sm[400 + j] + sm[528 + j] + sm[656 + j] + sm[784 + j];
        const float vn = beta * (sm[256 + j] - g * dt);
        float o = 0.f;
#pragma unroll
        for (int i = 0; i < 32; ++i) { const float kk = sm[128 + 32 * qd + i] * nk; S[i] = g * S[i] + kk * vn; o += S[i] * sm[32 * qd + i]; }
        sm[1024 + qd * 128 + j] = o * nq;
        __syncthreads();
        float ot = 0.f;
        if (tid < 128) { ot = sm[1024 + j] + sm[1152 + j] + sm[1280 + j] + sm[1408 + j]; const float ss = wave_sum(ot * ot); if (lane == 0) sm[392 + wid] = ss; }
        __syncthreads();
        if (tid < 128) { const float ms = (sm[392] + sm[393]) * (1.0f / 128.0f);
            Z[tok * DM + h * 128 + j] = f2bf(ot * rsqrtf(ms + 1e-6f) * dnw * zc); }
    }
    float* so = a.out + (prompt ? O_SSMP : O_SSMS) + ((size_t)b * 8 + h) * 128 * 128;
#pragma unroll
    for (int i = 0; i < 32; ++i) so[(size_t)(32 * qd + i) * 128 + j] = S[i];
    __syncthreads();
}
DI void phase_delta_seq(const Args& a, LAS unsigned char* lds) {
    for (int unit = blockIdx.x; unit < 64 + 1024; unit += gridDim.x) delta_seq_unit(a, (LAS float*)lds, unit);
}

typedef const __attribute__((address_space(4))) Args* KArgs;
#if defined(__HIP_DEVICE_COMPILE__)
#define LOAD_ARGS KArgs kp = (KArgs)__builtin_amdgcn_kernarg_segment_ptr(); asm volatile("" : "+s"(kp)); const Args a = *kp;
#else
#define LOAD_ARGS const Args a = a_;
#endif
#define PHASE(n, ...) if (ph_lo <= (n) && (n) < ph_hi) { if ((n) > ph_lo) cg::this_grid().sync(); LOAD_ARGS \
    unsigned char* ws = a.ws; float* out = a.out; (void)ws; (void)out; \
    bf16_t* XB = (bf16_t*)(ws + W_XB); bf16_t* Hh = (bf16_t*)(ws + W_Q); bf16_t* Uu = (bf16_t*)(ws + W_U); bf16_t* Zz = (bf16_t*)(ws + W_Z); \
    bf16_t* Gt = (bf16_t*)(out + O_Y); bf16_t* Vv = (bf16_t*)(out + O_SSMS); bf16_t* Mm = (bf16_t*)(ws + W_Q); float* M1 = (float*)(ws + W_M1); \
    (void)XB; (void)Hh; (void)Uu; (void)Zz; (void)Gt; (void)Vv; (void)Mm; (void)M1; __VA_ARGS__ }
__global__ void __launch_bounds__(512, 2) mk_fwd(Args a_) {
    extern __shared__ __attribute__((aligned(16))) unsigned char shm[];
    LAS unsigned char* lds = (LAS unsigned char*)shm;
    const int ph_lo = a_.ph_lo, ph_hi = a_.ph_hi;
    PHASE(0, phase_convert(a, lds);)
    PHASE(1, run_gemm(lds, XB, (const bf16_t*)(ws + W_UP1), 2 * DFF, DM, EpiSwiglu{Hh});)
    PHASE(2, run_gemm(lds, Hh, (const bf16_t*)(ws + W_DN1), DM, DFF, EpiRes<0>{out + O_Y, a.x_p, a.x_s, nullptr, 0.5f});)
    PHASE(3, phase_ln(out + O_Y, a.ln1g, a.ln1b, XB);)
    PHASE(4, run_gemm(lds, XB, (const bf16_t*)(ws + W_IN), NIN, DM, EpiProj{Uu, Vv, (bf16_t*)(ws + W_Q), Zz, Gt, (float*)(ws + W_BETA), (float*)(ws + W_GLOG), out + O_CONVP, out + O_CONVS,
                                                                      (const float*)(ws + W_BIN), a.alog, a.dtb});)
    PHASE(5, phase_vnorm(Vv, a.gmvg, a.gmvb, out + O_GMV);)
    PHASE(6, phase_mix(a, lds);)
    PHASE(7, phase_delta_seq(a, lds);)
    PHASE(8, run_gemm(lds, Uu, (const bf16_t*)(ws + W_BA), DM, DM, EpiM1{M1, Gt});
             run_gemm(lds, Zz, (const bf16_t*)(ws + W_BB), DM, DM, EpiM2{M1, Gt, Mm});)
    PHASE(9, run_gemm(lds, Mm, (const bf16_t*)(ws + W_WO), DM, DM, EpiRes<1>{out + O_Y, nullptr, nullptr, XB, 1.0f});)
    PHASE(10, phase_ln(out + O_Y, a.ln2g, a.ln2b, XB);)
    PHASE(11, run_gemm(lds, XB, (const bf16_t*)(ws + W_UP2), 2 * DFF, DM, EpiSwiglu{Hh});)
    PHASE(12, run_gemm(lds, Hh, (const bf16_t*)(ws + W_DN2), DM, DFF, EpiRes<1>{out + O_Y, nullptr, nullptr, XB, 0.5f});)
    PHASE(13, phase_ln(out + O_Y, a.ln3g, a.ln3b, nullptr);)
}

extern "C" void kernel_launch(void* const* d_in, const int* in_sizes, int n_in, void* d_out, int out_size, void* d_ws, size_t ws_size, hipStream_t stream) {
    static int grid = 0;
    if (grid == 0) {
        if (n_in != 27 || (size_t)out_size != O_END || ws_size < W_END) { fprintf(stderr, "kernel_launch: unexpected sizes n_in %d out %d ws %zu (need %zu)\n", n_in, out_size, ws_size, (size_t)W_END); grid = -1; return; }
        int dev = 0, cus = 0, per_cu = 0;
        (void)hipGetDevice(&dev); (void)hipDeviceGetAttribute(&cus, hipDeviceAttributeMultiprocessorCount, dev);
        if (hipFuncSetAttribute((const void*)mk_fwd, hipFuncAttributeMaxDynamicSharedMemorySize, LDS_BYTES) != hipSuccess) { fprintf(stderr, "kernel_launch: hipFuncSetAttribute failed\n"); grid = -1; return; }
        (void)hipOccupancyMaxActiveBlocksPerMultiprocessor(&per_cu, (const void*)mk_fwd, 512, LDS_BYTES);
        if (per_cu < 1) { fprintf(stderr, "kernel_launch: occupancy query gave %d\n", per_cu); per_cu = 1; }
        (void)hipGetLastError();
        grid = cus * 1;
    }
    if (grid < 0) return;
    Args a{};
    const float** f = (const float**)&a;
    for (int i = 0; i < 27; ++i) f[i] = (const float*)d_in[i];
    a.out = (float*)d_out; a.ws = (unsigned char*)d_ws;
#if MK_ONE_LAUNCH
    a.ph_lo = 0; a.ph_hi = 14;
    void* args[] = {&a};
    hipError_t e = hipLaunchCooperativeKernel((const void*)mk_fwd, dim3(grid), dim3(512), args, LDS_BYTES, stream);
    if (e != hipSuccess) fprintf(stderr, "cooperative launch failed: %s (grid %d)\n", hipGetErrorString(e), grid);
#else
    for (int ph = 0; ph < 14; ++ph) { a.ph_lo = ph; a.ph_hi = ph + 1; hipLaunchKernelGGL(mk_fwd, dim3(grid), dim3(512), LDS_BYTES, stream, a); }
#endif
}
```

```cpp
#define MK_ONE_LAUNCH 1
#include <hip/hip_runtime.h>
#include <hip/hip_cooperative_groups.h>
#include <cstdio>
namespace cg = cooperative_groups;
namespace pg8 {
#define PG8_LAS __attribute__((address_space(3)))
typedef unsigned short bf16_t;
typedef short bf16x8 __attribute__((ext_vector_type(8)));
typedef float f32x4 __attribute__((ext_vector_type(4)));
typedef unsigned u32x4 __attribute__((ext_vector_type(4)));
constexpr int BM = 256, BK = 64, HALF = 128, HTB = HALF * BK * 2  , STAGE_BYTES = 8 * HTB, NXCD = 8, WGM = 8;

__host__ __device__ __forceinline__ int lds_byte(int r, int c) { const int st = (r >> 4) * 2 + (c >> 5), rr = r & 15, cc = c & 31, ob = rr * 64 + cc * 2; return st * 1024 + (ob ^ (((ob >> 9) & 1) << 5)); }
__host__ __device__ __forceinline__ void stage_rc(int b, int& R, int& C) { const int st = b / 1024, sb = b % 1024, swz = sb ^ (((sb >> 9) & 1) << 5); R = (st >> 1) * 16 + swz / 64; C = (st & 1) * 32 + (swz % 64) / 2; }
__host__ __device__ __forceinline__ int perm32(int rho) { const int n = rho >> 4, i = rho & 15; return 8 * (i >> 2) + 4 * n + (i & 3); }
struct Unit { int pm, pn, kb; };
struct Gemm { const bf16_t* A; const bf16_t* Bt; int M, N, K, KL; };
struct StaticOrder {
    int nM, nN, nwg, G, c;
    __host__ __device__ void init(int M, int N, int G_, int c_) { nM = M / BM; nN = N / BM; nwg = nM * nN; G = G_; c = c_; }
    __host__ __device__ bool next(int i, Unit& u) const {
        const long L = (long)i * G + c; if (L >= nwg) return false;
        int wgid = (int)L; { const int q = nwg / NXCD, r = nwg % NXCD, xcd = wgid % NXCD, off = wgid / NXCD; wgid = (xcd < r ? xcd * (q + 1) : r * (q + 1) + (xcd - r) * q) + off; }
        const int nig = WGM * nN, gid = wgid / nig, fm = gid * WGM, gsz = (nM - fm) < WGM ? (nM - fm) : WGM;
        u.pm = fm + ((wgid % nig) % gsz); u.pn = (wgid % nig) / gsz; u.kb = 0; return true;
    }
    __device__ __forceinline__ void a_ready(const Unit&) const {}
    __device__ __forceinline__ void done(const Unit&) const {}
};
__device__ __forceinline__ unsigned cvt_pk_bf16(float lo, float hi) { unsigned r; asm volatile("v_cvt_pk_bf16_f32 %0, %1, %2" : "=v"(r) : "v"(lo), "v"(hi)); return r; }
template <class Epi, class Sched>
__device__ __forceinline__ void gemm_phase(PG8_LAS unsigned char* lds, const Gemm g, const Sched& S, const Epi& E) {
    const int tid = threadIdx.x, wid = __builtin_amdgcn_readfirstlane(tid >> 6), lane = tid & 63, wr = wid >> 2, wc = wid & 3, fr = lane & 15, fq = lane >> 4;
    const int K = g.K, nt = g.KL / BK;
    unsigned voffA[2], voffB[2];
#pragma unroll
    for (int i = 0; i < 2; ++i) { int R, C; stage_rc(tid * 16 + i * 8192, R, C); const int Rb = Epi::PERM ? ((R & ~31) + perm32(R & 31)) : R;
        voffA[i] = (unsigned)(R * K + C) * 2u; voffB[i] = (unsigned)(Rb * K + C) * 2u; }
    const size_t kstep = (size_t)(BK * 2);
    const size_t hstep = (size_t)HALF * K * 2;
    const size_t tstep = 2 * hstep;
    const unsigned ldsw = (unsigned)wid * 1024u;
    const int aoff = lds_byte(wr * 64 + fr, fq * 8), boff = lds_byte(wc * 32 + fr, fq * 8);
#define PG8_SA(b, h) (((b) * 2 + (h)) * HTB)
#define PG8_SB(b, h) ((4 + (b) * 2 + (h)) * HTB)
#define PG8_STAGE(bufoff, gbase, voff) do { _Pragma("unroll") for (int _i = 0; _i < 2; ++_i) \
        __builtin_amdgcn_global_load_lds((const unsigned*)((const char*)(gbase) + (voff)[_i]), (PG8_LAS unsigned*)(lds + (bufoff) + ldsw + _i * 8192), 16, 0, 0); } while (0)
#define PG8_LDA(dst, b, h) do { _Pragma("unroll") for (int m = 0; m < 4; ++m) _Pragma("unroll") for (int k = 0; k < 2; ++k) dst[m][k] = *(const PG8_LAS bf16x8*)(lds + PG8_SA(b, h) + aoff + m * 2048 + k * 1024); } while (0)
#define PG8_LDB(dst, b, h) do { _Pragma("unroll") for (int n = 0; n < 2; ++n) _Pragma("unroll") for (int k = 0; k < 2; ++k) dst[n][k] = *(const PG8_LAS bf16x8*)(lds + PG8_SB(b, h) + boff + n * 2048 + k * 1024); } while (0)
#define PG8_MMA(ai, bj, At, Bt) do { __builtin_amdgcn_s_setprio(1); _Pragma("unroll") for (int m = 0; m < 4; ++m) _Pragma("unroll") for (int n = 0; n < 2; ++n) _Pragma("unroll") for (int k = 0; k < 2; ++k) \
        acc[ai][bj][m][n] = __builtin_amdgcn_mfma_f32_16x16x32_bf16(Bt[n][k], At[m][k], acc[ai][bj][m][n], 0, 0, 0); __builtin_amdgcn_s_setprio(0); } while (0)
#define PG8_WAIT_V(n) asm volatile("s_waitcnt vmcnt(" #n ")" ::: "memory")
#define PG8_WAIT_L(n) asm volatile("s_waitcnt lgkmcnt(" #n ")" ::: "memory")
#define PG8_BAR __builtin_amdgcn_s_barrier()
#define PG8_SCHED __builtin_amdgcn_sched_barrier(0)
    Unit cur, nxt; int ui = 0;
    if (!S.next(0, cur)) return;
    f32x4 acc[2][2][4][2];
#pragma unroll
    for (int a = 0; a < 2; ++a)
#pragma unroll
        for (int b = 0; b < 2; ++b)
#pragma unroll
            for (int m = 0; m < 4; ++m)
#pragma unroll
                for (int n = 0; n < 2; ++n) acc[a][b][m][n] = (f32x4){0.f, 0.f, 0.f, 0.f};
    bf16x8 At[4][2], B0[2][2], B1[2][2];
    const char* cA = (const char*)g.A + (size_t)cur.pm * tstep + cur.kb; const char* cB = (const char*)g.Bt + (size_t)cur.pn * tstep + cur.kb;
    S.a_ready(cur);
    PG8_STAGE(PG8_SB(0, 0), cB, voffB); PG8_STAGE(PG8_SA(0, 0), cA, voffA); PG8_STAGE(PG8_SB(0, 1), cB + hstep, voffB); PG8_STAGE(PG8_SA(0, 1), cA + hstep, voffA);
    if (wr == 1) PG8_BAR;
    PG8_WAIT_V(4); PG8_BAR;
    PG8_STAGE(PG8_SB(1, 0), cB + kstep, voffB); PG8_STAGE(PG8_SA(1, 0), cA + kstep, voffA); PG8_STAGE(PG8_SB(1, 1), cB + hstep + kstep, voffB);
    PG8_WAIT_V(6); PG8_BAR;
    for (;;) {
        const bool has_next = S.next(ui + 1, nxt);
        const char* nA = has_next ? (const char*)g.A + (size_t)nxt.pm * tstep + nxt.kb : cA; const char* nB = has_next ? (const char*)g.Bt + (size_t)nxt.pn * tstep + nxt.kb : cB;
        for (int t = 0; t < nt; t += 2) {
            const bool last = (t == nt - 2);
            const char* a1 = cA + (size_t)(t + 1) * kstep;
            const char* a2 = last ? nA : cA + (size_t)(t + 2) * kstep; const char* b2 = last ? nB : cB + (size_t)(t + 2) * kstep;
            const char* a3 = a2 + kstep; const char* b3 = b2 + kstep;
            if (last && has_next) S.a_ready(nxt);
            PG8_LDB(B0, 0, 0); PG8_SCHED; PG8_LDA(At, 0, 0); PG8_STAGE(PG8_SA(1, 1), a1 + hstep, voffA);
            PG8_WAIT_L(8); PG8_BAR; PG8_WAIT_L(0); PG8_MMA(0, 0, At, B0); PG8_BAR; PG8_SCHED;
            PG8_LDB(B1, 0, 1); PG8_STAGE(PG8_SB(0, 0), b2, voffB);
            PG8_BAR; PG8_WAIT_L(0); PG8_MMA(0, 1, At, B1); PG8_BAR;
            PG8_LDA(At, 0, 1); PG8_STAGE(PG8_SA(0, 0), a2, voffA);
            PG8_BAR; PG8_WAIT_L(0); PG8_MMA(1, 0, At, B0); PG8_BAR; PG8_SCHED;
            PG8_STAGE(PG8_SB(0, 1), b2 + hstep, voffB);
            PG8_WAIT_V(6); PG8_BAR; PG8_MMA(1, 1, At, B1); PG8_BAR;
            PG8_LDB(B0, 1, 0); PG8_SCHED; PG8_LDA(At, 1, 0); PG8_STAGE(PG8_SA(0, 1), a2 + hstep, voffA);
            PG8_WAIT_L(8); PG8_BAR; PG8_WAIT_L(0); PG8_MMA(0, 0, At, B0); PG8_BAR; PG8_SCHED;
            PG8_LDB(B1, 1, 1); PG8_STAGE(PG8_SB(1, 0), b3, voffB);
            PG8_BAR; PG8_WAIT_L(0); PG8_MMA(0, 1, At, B1); PG8_BAR;
            PG8_LDA(At, 1, 1); PG8_STAGE(PG8_SA(1, 0), a3, voffA);
            PG8_BAR; PG8_WAIT_L(0); PG8_MMA(1, 0, At, B0); PG8_BAR; PG8_SCHED;
            PG8_STAGE(PG8_SB(1, 1), b3 + hstep, voffB);
            PG8_WAIT_V(6); PG8_BAR; PG8_MMA(1, 1, At, B1); PG8_BAR;
        }
        if constexpr (!Epi::AFTER_DRAIN) { E(acc, cur, wr, wc, fr, fq); S.done(cur); }
        if (!has_next) break;
#pragma unroll
        for (int a = 0; a < 2; ++a)
#pragma unroll
            for (int b = 0; b < 2; ++b)
#pragma unroll
                for (int m = 0; m < 4; ++m)
#pragma unroll
                    for (int n = 0; n < 2; ++n) acc[a][b][m][n] = (f32x4){0.f, 0.f, 0.f, 0.f};
        cur = nxt; cA = nA; cB = nB; ++ui;
    }
    PG8_WAIT_V(0);
    if (wr == 0) PG8_BAR;
    PG8_BAR;
    if constexpr (Epi::AFTER_DRAIN) { E.fused(acc, cur, wr, wc, fr, fq, lds, wid, lane); S.done(cur); }
#undef PG8_SA
#undef PG8_SB
#undef PG8_STAGE
#undef PG8_LDA
#undef PG8_LDB
#undef PG8_MMA
#undef PG8_WAIT_V
#undef PG8_WAIT_L
#undef PG8_BAR
#undef PG8_SCHED
}
}
using pg8::bf16_t; using pg8::bf16x8; using pg8::f32x4; using pg8::u32x4;
#define LAS __attribute__((address_space(3)))
typedef float f32x16 __attribute__((ext_vector_type(16)));
typedef unsigned u32x2 __attribute__((ext_vector_type(2)));
#define DI __device__ __forceinline__

constexpr int DM = 1024, MP = 16384, MS = 512, MT = MP + MS, SEQ = 2048, DFF = 2816, NIN = 8448, NQKV = 3072;
constexpr float ALPHA = 1.189207115002721f;
constexpr size_t O_Y = 0, O_CONVP = (size_t)MT * DM, O_SSMP = O_CONVP + 8 * 3 * 3072, O_CONVS = O_SSMP + (size_t)8 * 8 * 128 * 128,
                 O_SSMS = O_CONVS + (size_t)128 * 3 * 3072, O_GMV = O_SSMS + (size_t)128 * 8 * 128 * 128, O_END = O_GMV + (size_t)MS * DM;
constexpr size_t W_UP1 = 0, W_DN1 = W_UP1 + (size_t)2 * DFF * DM * 2, W_IN = W_DN1 + (size_t)DM * DFF * 2, W_BA = W_IN + (size_t)NIN * DM * 2,
                 W_BB = W_BA + (size_t)DM * DM * 2, W_WO = W_BB + (size_t)DM * DM * 2, W_UP2 = W_WO + (size_t)DM * DM * 2, W_DN2 = W_UP2 + (size_t)2 * DFF * DM * 2,
                 W_BIN = W_DN2 + (size_t)DM * DFF * 2, W_BETA = W_BIN + (size_t)NIN * 4, W_GLOG = W_BETA + (size_t)MT * 8 * 4, W_XB = W_GLOG + (size_t)MT * 8 * 4,
                 W_U = W_XB + (size_t)MT * DM * 2, W_Z = W_U + (size_t)MT * DM * 2, W_Q = W_Z + (size_t)MT * DM * 2, W_M1 = W_Q + (size_t)MT * DM * 2,
                 W_STAT = W_Q + (size_t)MT * NQKV * 2, W_BAR = W_STAT + (size_t)MT * 2 * 4, W_END = W_BAR + 16384;
constexpr int LDS_BYTES = pg8::STAGE_BYTES + 12288;

struct Args {
    const float *x_p, *x_s, *st_conv, *st_ssm, *up1, *dn1, *ln1g, *ln1b, *w_in, *b_in, *gmvg, *gmvb, *gmws, *gmbs, *convw, *alog, *dtb, *dnw, *wba, *wbb, *wo, *ln2g, *ln2b, *up2, *dn2, *ln3g, *ln3b;
    float* out; unsigned char* ws; int ph_lo, ph_hi;
};

DI bf16_t f2bf(float x) { unsigned u = __float_as_uint(x); u += 0x7fffu + ((u >> 16) & 1u); return (bf16_t)(u >> 16); }
DI float bf2f(bf16_t b) { return __uint_as_float(((unsigned)b) << 16); }
DI float bflo(unsigned w) { return __uint_as_float(w << 16); }
DI float bfhi(unsigned w) { return __uint_as_float(w & 0xffff0000u); }
DI unsigned pk2(float lo, float hi) { return (unsigned)f2bf(lo) | ((unsigned)f2bf(hi) << 16); }
typedef __bf16 bf2_t __attribute__((ext_vector_type(2)));
typedef float f32x2 __attribute__((ext_vector_type(2)));
DI unsigned cvt2(float lo, float hi) { const f32x2 v = {lo, hi}; return __builtin_bit_cast(unsigned, __builtin_convertvector(v, bf2_t)); }
DI float sigmoidf_(float x) { return __builtin_amdgcn_rcpf(1.0f + __builtin_amdgcn_exp2f(-1.4426950408889634f * x)); }
DI float siluf_(float x) { return x * sigmoidf_(x); }
DI float gelu_tanh(float x) { const float u = 0.7978845608028654f * (x + 0.044715f * x * x * x); return x * sigmoidf_(2.0f * u); }
DI float softplusf_(float x) { return fmaxf(x, 0.f) + log1pf(__expf(-fabsf(x))); }
DI float wave_sum(float v) {
#pragma unroll
    for (int o = 32; o > 0; o >>= 1) v += __shfl_xor(v, o, 64);
    return v;
}

DI int src_col16(int mode, int n16) {
    if (mode == 0) return n16;
    if (mode == 1) { const int tile = n16 >> 8, within = n16 & 255; return (within >> 7) * DFF + tile * 128 + (within & 127); }
    if (n16 < 6144) return n16;
    if (n16 < 8192) return n16 + 16;
    if (n16 < 8208) return n16 - 8192 + 6144;
    return -1;
}
DI void convert_weight(const float* __restrict__ src, int K, int ld, bf16_t* __restrict__ dst, int Nd, int mode, LAS bf16_t* tile, int bi, int G) {
    const int tid = threadIdx.x, tk = K / 64, ntiles = (Nd / 64) * tk, krow = tid >> 3, cseg = tid & 7;
    f32x4 pa = {0.f, 0.f, 0.f, 0.f}, pb = pa;
    auto fetch = [&](int t) { const int n0 = (t / tk) * 64, k0 = (t % tk) * 64; const int sc = src_col16(mode, n0 + (cseg >> 1) * 16);
        pa = (f32x4){0.f, 0.f, 0.f, 0.f}; pb = pa;
        if (sc >= 0) { const float* p = src + (size_t)(k0 + krow) * ld + sc + (cseg & 1) * 8; pa = *(const f32x4*)p; pb = *(const f32x4*)(p + 4); } };
    if (bi < ntiles) fetch(bi);
    for (int t = bi; t < ntiles; t += G) {
        const int n0 = (t / tk) * 64, k0 = (t % tk) * 64;
        const f32x4 a = pa, b = pb;
        if (t + G < ntiles) fetch(t + G);
#pragma unroll
        for (int i = 0; i < 4; ++i) { tile[(cseg * 8 + i) * 72 + krow] = f2bf(a[i]); tile[(cseg * 8 + 4 + i) * 72 + krow] = f2bf(b[i]); }
        __syncthreads();
        { const int nl = tid >> 3, ks = tid & 7; const u32x4 v = *(const LAS u32x4*)(tile + nl * 72 + ks * 8);
          *(u32x4*)(dst + (size_t)(n0 + nl) * K + k0 + ks * 8) = v; }
        __syncthreads();
    }
}
DI void phase_convert(const Args& a, LAS unsigned char* lds) {
    LAS bf16_t* tile = (LAS bf16_t*)lds;
    unsigned char* ws = a.ws;
    const int bi = (int)blockIdx.x, G = (int)gridDim.x;
    convert_weight(a.up1, DM, 2 * DFF, (bf16_t*)(ws + W_UP1), 2 * DFF, 1, tile, bi, G);
    convert_weight(a.dn1, DFF, DM, (bf16_t*)(ws + W_DN1), DM, 0, tile, bi, G);
    {
        convert_weight(a.w_in, DM, 8208, (bf16_t*)(ws + W_IN), NIN, 2, tile, bi, G);
        convert_weight(a.up2, DM, 2 * DFF, (bf16_t*)(ws + W_UP2), 2 * DFF, 1, tile, bi, G);
        convert_weight(a.dn2, DFF, DM, (bf16_t*)(ws + W_DN2), DM, 0, tile, bi, G); }
    convert_weight(a.wba, DM, DM, (bf16_t*)(ws + W_BA), DM, 0, tile, bi, G);
    convert_weight(a.wbb, DM, DM, (bf16_t*)(ws + W_BB), DM, 0, tile, bi, G);
    convert_weight(a.wo, DM, DM, (bf16_t*)(ws + W_WO), DM, 0, tile, bi, G);
    const size_t gt = (size_t)blockIdx.x * blockDim.x + threadIdx.x, gn = (size_t)gridDim.x * blockDim.x;
    float* binr = (float*)(ws + W_BIN);
    for (size_t i = gt; i < (size_t)NIN; i += gn) { const int sc = src_col16(2, (int)i & ~15); binr[i] = sc >= 0 ? a.b_in[sc + ((int)i & 15)] : 0.f; }
    float* stat = (float*)(ws + W_STAT);
    for (size_t i = gt; i < (size_t)MT * 2; i += gn) stat[i] = 0.f;
    bf16_t* xb = (bf16_t*)(ws + W_XB);
    for (size_t i0 = gt; i0 < (size_t)MT * DM / 8; i0 += 4 * gn) {
        f32x4 v0[4], v1[4];
#pragma unroll
        for (int k = 0; k < 4; ++k) { const size_t i = i0 + k * gn; if (i < (size_t)MT * DM / 8) { const size_t e = i * 8; const float* p = e < (size_t)MP * DM ? a.x_p + e : a.x_s + (e - (size_t)MP * DM);
            v0[k] = *(const f32x4*)p; v1[k] = *(const f32x4*)(p + 4); } }
#pragma unroll
        for (int k = 0; k < 4; ++k) { const size_t i = i0 + k * gn; if (i < (size_t)MT * DM / 8) {
            u32x4 w; w.x = cvt2(v0[k][0], v0[k][1]); w.y = cvt2(v0[k][2], v0[k][3]); w.z = cvt2(v1[k][0], v1[k][1]); w.w = cvt2(v1[k][2], v1[k][3]);
            *(u32x4*)(xb + i * 8) = w; } }
    }
}

struct EpiSwiglu {
    static constexpr bool PERM = true, AFTER_DRAIN = false;
    bf16_t* H;
    DI void operator()(const f32x4 (&acc)[2][2][4][2], const pg8::Unit& u, int wr, int wc, int fr, int fq) const {
        const int row0 = u.pm * 256 + wr * 64 + fr, h0 = u.pn * 128 + wc * 32 + 8 * fq;
#pragma unroll
        for (int ai = 0; ai < 2; ++ai)
#pragma unroll
            for (int m = 0; m < 4; ++m) { bf16_t* rowp = H + (size_t)(row0 + ai * 128 + m * 16) * DFF + h0;
                const f32x4 x0 = acc[ai][0][m][0], x1 = acc[ai][0][m][1], g0 = acc[ai][1][m][0], g1 = acc[ai][1][m][1];
                u32x4 w; w.x = cvt2(siluf_(x0[0]) * g0[0], siluf_(x0[1]) * g0[1]); w.y = cvt2(siluf_(x0[2]) * g0[2], siluf_(x0[3]) * g0[3]);
                w.z = cvt2(siluf_(x1[0]) * g1[0], siluf_(x1[1]) * g1[1]); w.w = cvt2(siluf_(x1[2]) * g1[2], siluf_(x1[3]) * g1[3]);
                *(u32x4*)rowp = w; }
    }
};
template <int RES  > struct EpiRes {
    static constexpr bool PERM = false, AFTER_DRAIN = false;
    float* R; const float* xp; const float* xs; const bf16_t* xb; float scale;
    DI void operator()(const f32x4 (&acc)[2][2][4][2], const pg8::Unit& u, int wr, int wc, int fr, int fq) const {
        const int row0 = u.pm * 256 + wr * 64 + fr, col0 = u.pn * 256 + wc * 32 + 4 * fq;
#pragma unroll
        for (int ai = 0; ai < 2; ++ai)
#pragma unroll
            for (int m = 0; m < 4; ++m) { const int row = row0 + ai * 128 + m * 16;
#pragma unroll
                for (int bj = 0; bj < 2; ++bj)
#pragma unroll
                    for (int n = 0; n < 2; ++n) { const int col = col0 + bj * 128 + n * 16; f32x4 r;
                        if (RES == 0) { const float* p = row < MP ? xp + (size_t)row * DM + col : xs + (size_t)(row - MP) * DM + col; r = *(const f32x4*)p; }
                        else { const u32x2 w = *(const u32x2*)(xb + (size_t)row * DM + col); r = (f32x4){bflo(w.x), bfhi(w.x), bflo(w.y), bfhi(w.y)}; }
                        *(f32x4*)(R + (size_t)row * DM + col) = r * ALPHA + acc[ai][bj][m][n] * scale; } }
    }
};
struct EpiProj {
    static constexpr bool PERM = true, AFTER_DRAIN = false;
    bf16_t *U, *V, *QKV, *Z, *G, *side; float *beta, *glog, *convp, *convs, *stat; const float *bias, *alog, *dtb;
    template <int MODE> DI void body(const f32x4 (&acc)[2][2][4][2], int pn, int row0, int wc, int fq) const {
#pragma unroll
        for (int bj = 0; bj < 2; ++bj) {
            const int col = pn * 256 + wc * 32 + 8 * fq + bj * 128;
            const f32x4 b0 = *(const f32x4*)(bias + col), b1 = *(const f32x4*)(bias + col + 4);
#pragma unroll
            for (int ai = 0; ai < 2; ++ai)
#pragma unroll
                for (int m = 0; m < 4; ++m) {
                    const int row = row0 + ai * 128 + m * 16;
                    f32x4 v0 = acc[ai][bj][m][0] + b0, v1 = acc[ai][bj][m][1] + b1;
                    if (MODE == 5) {
                        const int c = col - 8192;
                        if (c == 0) { f32x4 o0, o1;
#pragma unroll
                            for (int j = 0; j < 4; ++j) { o0[j] = sigmoidf_(v0[j]); o1[j] = sigmoidf_(v1[j]); }
                            *(f32x4*)(beta + (size_t)row * 8) = o0; *(f32x4*)(beta + (size_t)row * 8 + 4) = o1; }
                        if (c == 8) { f32x4 o0, o1;
#pragma unroll
                            for (int j = 0; j < 4; ++j) { o0[j] = -__expf(alog[j]) * softplusf_(v0[j] + dtb[j]); o1[j] = -__expf(alog[4 + j]) * softplusf_(v1[j] + dtb[4 + j]); }
                            *(f32x4*)(glog + (size_t)row * 8) = o0; *(f32x4*)(glog + (size_t)row * 8 + 4) = o1; }
                    } else {
                        bf16_t* dst;
                        if (MODE == 0 || MODE == 1) {
#pragma unroll
                            for (int j = 0; j < 4; ++j) { v0[j] = gelu_tanh(v0[j]); v1[j] = gelu_tanh(v1[j]); }
                            if (MODE == 1) {
                                float s = v0[0] + v0[1] + v0[2] + v0[3] + v1[0] + v1[1] + v1[2] + v1[3];
                                float q = v0[0] * v0[0] + v0[1] * v0[1] + v0[2] * v0[2] + v0[3] * v0[3] + v1[0] * v1[0] + v1[1] * v1[1] + v1[2] * v1[2] + v1[3] * v1[3];
                                s += __shfl_xor(s, 16, 64); q += __shfl_xor(q, 16, 64); s += __shfl_xor(s, 32, 64); q += __shfl_xor(q, 32, 64);
                                if (fq == 0) { atomicAdd(stat + (size_t)row * 2, s); atomicAdd(stat + (size_t)row * 2 + 1, q); } }
                            dst = (MODE == 0 ? U + (size_t)row * DM + col : V + (size_t)row * DM + (col - 1024));
                        } else if (MODE == 2) {
                            const int c = col - 2048; dst = QKV + (size_t)row * NQKV + c;
                            float* cp = nullptr;
                            if (row < MP) { const int t = row & (SEQ - 1); if (t >= SEQ - 3) cp = convp + ((size_t)(row >> 11) * 3 + (t - (SEQ - 3))) * NQKV + c; }
                            else { const int r = row - MP, t = r & 3; if (t >= 1) cp = convs + ((size_t)(r >> 2) * 3 + (t - 1)) * NQKV + c; }
                            if (cp) { *(f32x4*)cp = v0; *(f32x4*)(cp + 4) = v1; }
                            if (row < MP) { const int t6 = row & 63, nc = (row >> 6) + 1;
                                if (t6 >= 61 && (nc & 31) != 0) { u32x4 w; w.x = cvt2(v0[0], v0[1]); w.y = cvt2(v0[2], v0[3]); w.z = cvt2(v1[0], v1[1]); w.w = cvt2(v1[2], v1[3]);
                                    *(u32x4*)(side + ((size_t)nc * 3 + (t6 - 61)) * NQKV + c) = w; } }
                        } else if (MODE == 3) {
#pragma unroll
                            for (int j = 0; j < 4; ++j) { v0[j] = siluf_(v0[j]); v1[j] = siluf_(v1[j]); }
                            dst = Z + (size_t)row * DM + (col - 5120);
                        } else {
#pragma unroll
                            for (int j = 0; j < 4; ++j) { v0[j] = sigmoidf_(v0[j]); v1[j] = sigmoidf_(v1[j]); }
                            dst = G + (size_t)row * 2048 + (col - 6144);
                        }
                        u32x4 w; w.x = cvt2(v0[0], v0[1]); w.y = cvt2(v0[2], v0[3]); w.z = cvt2(v1[0], v1[1]); w.w = cvt2(v1[2], v1[3]);
                        *(u32x4*)dst = w;
                    }
                }
        }
    }
    DI void operator()(const f32x4 (&acc)[2][2][4][2], const pg8::Unit& u, int wr, int wc, int fr, int fq) const {
        const int row0 = u.pm * 256 + wr * 64 + fr, pn = u.pn;
        if (pn < 4) body<0>(acc, pn, row0, wc, fq);
        else if (pn < 8) body<1>(acc, pn, row0, wc, fq);
        else if (pn < 20) body<2>(acc, pn, row0, wc, fq);
        else if (pn < 24) body<3>(acc, pn, row0, wc, fq);
        else if (pn < 32) body<4>(acc, pn, row0, wc, fq);
        else body<5>(acc, pn, row0, wc, fq);
    }
};
struct EpiM1 {
    static constexpr bool PERM = false, AFTER_DRAIN = false;
    bf16_t* G;
    DI void operator()(const f32x4 (&acc)[2][2][4][2], const pg8::Unit& u, int wr, int wc, int fr, int fq) const {
        const int row0 = u.pm * 256 + wr * 64 + fr, col0 = u.pn * 256 + wc * 32 + 4 * fq;
#pragma unroll
        for (int ai = 0; ai < 2; ++ai)
#pragma unroll
            for (int m = 0; m < 4; ++m) { const int row = row0 + ai * 128 + m * 16;
#pragma unroll
                for (int bj = 0; bj < 2; ++bj)
#pragma unroll
                    for (int n = 0; n < 2; ++n) { const int col = col0 + bj * 128 + n * 16; bf16_t* p = G + (size_t)row * 2048 + col;
                        const u32x2 w = *(const u32x2*)p; const f32x4 v = (f32x4){bflo(w.x), bfhi(w.x), bflo(w.y), bfhi(w.y)} * acc[ai][bj][m][n];
                        u32x2 o; o.x = cvt2(v[0], v[1]); o.y = cvt2(v[2], v[3]); *(u32x2*)p = o; } asm volatile("" ::: "memory"); }
    }
};
struct EpiM2 {
    static constexpr bool PERM = false, AFTER_DRAIN = false;
    const bf16_t* G; bf16_t* Mm;
    DI void operator()(const f32x4 (&acc)[2][2][4][2], const pg8::Unit& u, int wr, int wc, int fr, int fq) const {
        const int row0 = u.pm * 256 + wr * 64 + fr, col0 = u.pn * 256 + wc * 32 + 4 * fq;
#pragma unroll
        for (int ai = 0; ai < 2; ++ai)
#pragma unroll
            for (int m = 0; m < 4; ++m) { const int row = row0 + ai * 128 + m * 16;
#pragma unroll
                for (int bj = 0; bj < 2; ++bj)
#pragma unroll
                    for (int n = 0; n < 2; ++n) { const int col = col0 + bj * 128 + n * 16; const bf16_t* p = G + (size_t)row * 2048 + col;
                        const u32x2 w1 = *(const u32x2*)p, w = *(const u32x2*)(p + 1024);
                        const f32x4 v = (f32x4){bflo(w1.x), bfhi(w1.x), bflo(w1.y), bfhi(w1.y)} + (f32x4){bflo(w.x), bfhi(w.x), bflo(w.y), bfhi(w.y)} * acc[ai][bj][m][n];
                        u32x2 o; o.x = cvt2(v[0], v[1]); o.y = cvt2(v[2], v[3]);
                        *(u32x2*)(Mm + (size_t)row * DM + col) = o; } asm volatile("" ::: "memory"); }
    }
};
template <class Epi> DI void run_gemm(LAS unsigned char* lds, const bf16_t* A, const bf16_t* Bt, int N, int K, const Epi& E) {
    pg8::Gemm g{A, Bt, MT, N, K, K}; pg8::StaticOrder S; S.init(MT, N, (int)gridDim.x, (int)blockIdx.x);
    pg8::gemm_phase<Epi, pg8::StaticOrder>(lds, g, S, E);
}
struct SplitOrder {
    int nsplit, nsub, G, c;
    DI void init(int K, int G_, int c_) { nsplit = K / 256; nsub = 8 * nsplit; G = G_; c = c_; }
    DI bool next(int i, pg8::Unit& u) const { const int s = i * G + c; if (s >= nsub) return false; const int tile = s / nsplit, ks = s - tile * nsplit; u.pm = MP / 256 + (tile >> 2); u.pn = tile & 3; u.kb = ks * 512; return true; }
    DI void a_ready(const pg8::Unit&) const {}
    DI void done(const pg8::Unit&) const {}
};
struct EpiPartial {
    static constexpr bool PERM = false, AFTER_DRAIN = false;
    float* P;
    DI void operator()(const f32x4 (&acc)[2][2][4][2], const pg8::Unit& u, int wr, int wc, int fr, int fq) const {
        const int row0 = (u.pm - MP / 256) * 256 + wr * 64 + fr, col0 = u.pn * 256 + wc * 32 + 4 * fq; float* base = P + (size_t)(u.kb >> 9) * MS * DM;
#pragma unroll
        for (int ai = 0; ai < 2; ++ai)
#pragma unroll
            for (int m = 0; m < 4; ++m) { float* rowp = base + (size_t)(row0 + ai * 128 + m * 16) * DM + col0;
#pragma unroll
                for (int bj = 0; bj < 2; ++bj)
#pragma unroll
                    for (int n = 0; n < 2; ++n) *(f32x4*)(rowp + bj * 128 + n * 16) = acc[ai][bj][m][n]; }
    }
};
template <class Epi> DI void run_gemm_res(LAS unsigned char* lds, const bf16_t* A, const bf16_t* Bt, int K, const Epi& E, float* P) {
    { pg8::Gemm g{A, Bt, MP, DM, K, K}; pg8::StaticOrder S; S.init(MP, DM, (int)gridDim.x, (int)blockIdx.x); pg8::gemm_phase<Epi, pg8::StaticOrder>(lds, g, S, E); }
    { pg8::Gemm g{A, Bt, MT, DM, K, 256}; SplitOrder S; S.init(K, (int)gridDim.x, (int)blockIdx.x); pg8::gemm_phase<EpiPartial, SplitOrder>(lds, g, S, EpiPartial{P}); }
}

DI void phase_ln(float* __restrict__ R, const float* __restrict__ g, const float* __restrict__ b, bf16_t* __restrict__ xb, const float* P, int nsplit, float scale, const float* xs, const bf16_t* resb) {
    const int lane = threadIdx.x & 63, wv = blockIdx.x * 8 + (threadIdx.x >> 6), nw = gridDim.x * 8;
    f32x4 gg[4], bb[4];
#pragma unroll
    for (int i = 0; i < 4; ++i) { gg[i] = *(const f32x4*)(g + 4 * lane + 256 * i); bb[i] = *(const f32x4*)(b + 4 * lane + 256 * i); }
    for (int row = wv; row < MT; row += nw) {
        float* p = R + (size_t)row * DM + 4 * lane; f32x4 v[4]; float s = 0.f;
        if (row < MP) {
#pragma unroll
            for (int i = 0; i < 4; ++i) v[i] = *(const f32x4*)(p + 256 * i);
        } else {
            const size_t ro = (size_t)(row - MP) * DM + 4 * lane;
#pragma unroll
            for (int i = 0; i < 4; ++i) { v[i] = (f32x4){0.f, 0.f, 0.f, 0.f};
                for (int k = 0; k < nsplit; ++k) v[i] += *(const f32x4*)(P + (size_t)k * MS * DM + ro + 256 * i);
                f32x4 r;
                if (xs) r = *(const f32x4*)(xs + ro + 256 * i);
                else { const u32x2 w = *(const u32x2*)(resb + (size_t)row * DM + 4 * lane + 256 * i); r = (f32x4){bflo(w.x), bfhi(w.x), bflo(w.y), bfhi(w.y)}; }
                v[i] = r * ALPHA + v[i] * scale; }
        }
#pragma unroll
        for (int i = 0; i < 4; ++i) s += v[i][0] + v[i][1] + v[i][2] + v[i][3];
        const float mu = wave_sum(s) * (1.0f / DM); float q = 0.f;
#pragma unroll
        for (int i = 0; i < 4; ++i) { v[i] -= mu; q += v[i][0] * v[i][0] + v[i][1] * v[i][1] + v[i][2] * v[i][2] + v[i][3] * v[i][3]; }
        const float rs = rsqrtf(wave_sum(q) * (1.0f / DM) + 1e-5f);
#pragma unroll
        for (int i = 0; i < 4; ++i) { const f32x4 y = v[i] * rs * gg[i] + bb[i];
            if (xb) { u32x2 w; w.x = pk2(y[0], y[1]); w.y = pk2(y[2], y[3]); *(u32x2*)(xb + (size_t)row * DM + 4 * lane + 256 * i) = w; }
            else *(f32x4*)(p + 256 * i) = y; }
    }
}
DI void phase_vnorm(bf16_t* __restrict__ V, const float* __restrict__ g, const float* __restrict__ b, float* __restrict__ gmv) {
    const int lane = threadIdx.x & 63, wv = blockIdx.x * 8 + (threadIdx.x >> 6), nw = gridDim.x * 8;
    for (int row = wv; row < MT; row += nw) {
        bf16_t* p = V + (size_t)row * DM + 8 * lane; float v[16]; float s = 0.f;
#pragma unroll
        for (int i = 0; i < 2; ++i) { const u32x4 w = *(const u32x4*)(p + 512 * i);
            v[8 * i + 0] = bflo(w.x); v[8 * i + 1] = bfhi(w.x); v[8 * i + 2] = bflo(w.y); v[8 * i + 3] = bfhi(w.y);
            v[8 * i + 4] = bflo(w.z); v[8 * i + 5] = bfhi(w.z); v[8 * i + 6] = bflo(w.w); v[8 * i + 7] = bfhi(w.w); }
#pragma unroll
        for (int i = 0; i < 16; ++i) s += v[i];
        const float mu = wave_sum(s) * (1.0f / DM); float q = 0.f;
#pragma unroll
        for (int i = 0; i < 16; ++i) { v[i] -= mu; q += v[i] * v[i]; }
        const float rs = rsqrtf(wave_sum(q) * (1.0f / DM) + 1e-5f);
#pragma unroll
        for (int i = 0; i < 2; ++i) { const int c = 8 * lane + 512 * i;
            const f32x4 g0 = *(const f32x4*)(g + c), g1 = *(const f32x4*)(g + c + 4), b0 = *(const f32x4*)(b + c), b1 = *(const f32x4*)(b + c + 4);
            f32x4 y0, y1;
#pragma unroll
            for (int j = 0; j < 4; ++j) { y0[j] = v[8 * i + j] * rs * g0[j] + b0[j]; y1[j] = v[8 * i + 4 + j] * rs * g1[j] + b1[j]; }
            u32x4 w; w.x = pk2(y0[0], y0[1]); w.y = pk2(y0[2], y0[3]); w.z = pk2(y1[0], y1[1]); w.w = pk2(y1[2], y1[3]);
            *(u32x4*)(p + 512 * i) = w;
            if (row >= MP) { float* o = gmv + (size_t)(row - MP) * DM + c; *(f32x4*)o = y0; *(f32x4*)(o + 4) = y1; } }
    }
}

DI int crow(int reg, int h) { return (reg & 3) + 8 * (reg >> 2) + 4 * h; }
DI void phase_mix(const Args& a, LAS unsigned char* lds, bool dry) {
    bf16_t* U = (bf16_t*)(a.ws + W_U); const bf16_t* V = (const bf16_t*)(a.out + O_SSMS); const float* stat = (const float*)(a.ws + W_STAT);
    LAS bf16_t* vt = (LAS bf16_t*)lds;
    const int tid0 = threadIdx.x;
#pragma unroll 1
    for (int tile = blockIdx.x; tile < 1024; tile += gridDim.x) {
        int tid = tid0; asm volatile("" : "+v"(tid));
        const int lane = tid & 63, wid = tid >> 6, r = lane & 31, h = lane >> 5, rb = wid >> 1, ch = wid & 1;
        const int g = tile & 7, bc = tile >> 3; const size_t tok0 = (size_t)bc * 128;
        const int t = 32 * rb + r; const float* wrow = a.gmws + ((size_t)g * 128 + t) * 128;
        __syncthreads();
#pragma unroll
        for (int i = 0; i < 4; ++i) { const int e = tid + 512 * i, s = e >> 4, seg = e & 15, cc = g * 128 + seg * 8;
            const u32x4 w = *(const u32x4*)(V + (tok0 + s) * DM + cc);
            const float sm_ = stat[(tok0 + s) * 2], sq_ = stat[(tok0 + s) * 2 + 1], mu = sm_ * (1.0f / DM), rs = rsqrtf(fmaxf(sq_ * (1.0f / DM) - mu * mu, 0.f) + 1e-5f);
            const f32x4 g0 = *(const f32x4*)(a.gmvg + cc), g1 = *(const f32x4*)(a.gmvg + cc + 4), b0 = *(const f32x4*)(a.gmvb + cc), b1 = *(const f32x4*)(a.gmvb + cc + 4);
            u32x4 o;
            o.x = pk2((bflo(w.x) - mu) * rs * g0[0] + b0[0], (bfhi(w.x) - mu) * rs * g0[1] + b0[1]); o.y = pk2((bflo(w.y) - mu) * rs * g0[2] + b0[2], (bfhi(w.y) - mu) * rs * g0[3] + b0[3]);
            o.z = pk2((bflo(w.z) - mu) * rs * g1[0] + b1[0], (bfhi(w.z) - mu) * rs * g1[1] + b1[1]); o.w = pk2((bflo(w.w) - mu) * rs * g1[2] + b1[2], (bfhi(w.w) - mu) * rs * g1[3] + b1[3]);
            *(LAS u32x4*)(vt + s * 136 + seg * 8) = o; }
        __syncthreads();
        f32x16 acc[2];
#pragma unroll
        for (int i = 0; i < 16; ++i) { acc[0][i] = 0.f; acc[1][i] = 0.f; }
#pragma unroll 2
        for (int ks = 0; ks < 2 * rb + 2; ++ks) {
            const int s0 = 16 * ks + 8 * h;
            const f32x4 w0 = *(const f32x4*)(wrow + s0), w1 = *(const f32x4*)(wrow + s0 + 4);
            bf16x8 af;
#pragma unroll
            for (int j = 0; j < 4; ++j) { af[j] = (short)f2bf(s0 + j <= t ? w0[j] : 0.f); af[4 + j] = (short)f2bf(s0 + 4 + j <= t ? w1[j] : 0.f); }
#pragma unroll
            for (int nb = 0; nb < 2; ++nb) { bf16x8 bfr;
#pragma unroll
                for (int j = 0; j < 8; ++j) bfr[j] = (short)vt[(s0 + j) * 136 + 64 * ch + 32 * nb + r];
                acc[nb] = __builtin_amdgcn_mfma_f32_32x32x16_bf16(af, bfr, acc[nb], 0, 0, 0); }
        }
#pragma unroll
        for (int nb = 0; nb < 2; ++nb)
#pragma unroll
            for (int i = 0; i < 16; ++i) { const int tt = 32 * rb + crow(i, h), dd = 64 * ch + 32 * nb + r;
                bf16_t* p = U + (tok0 + tt) * DM + g * 128 + dd; const bf16_t o_ = f2bf(bf2f(*p) * (acc[nb][i] + a.gmbs[g * 128 + tt])); if (!dry) *p = o_; }
    }
    for (int e = blockIdx.x * 512 + tid0; e < 128 * DM; e += gridDim.x * 512) {
        const int sq = e >> 10, c = e & 1023, g = c >> 7; const size_t row0 = (size_t)MP + sq * 4, base = row0 * DM + c;
        const float gg = a.gmvg[c], bb = a.gmvb[c];
        float v[4];
#pragma unroll
        for (int s = 0; s < 4; ++s) { const float sm_ = stat[(row0 + s) * 2], sq_ = stat[(row0 + s) * 2 + 1], mu = sm_ * (1.0f / DM), rs = rsqrtf(fmaxf(sq_ * (1.0f / DM) - mu * mu, 0.f) + 1e-5f);
            const float y = (bf2f(V[base + (size_t)s * DM]) - mu) * rs * gg + bb; if (!dry) a.out[O_GMV + ((size_t)sq * 4 + s) * DM + c] = y; v[s] = y; }
#pragma unroll
        for (int t = 0; t < 4; ++t) { float m = a.gmbs[g * 128 + t];
#pragma unroll
            for (int s = 0; s <= t; ++s) m += a.gmws[((size_t)g * 128 + t) * 128 + s] * v[s];
            bf16_t* p = U + base + (size_t)t * DM; const bf16_t o_ = f2bf(bf2f(*p) * m); if (!dry) *p = o_; }
    }
    __syncthreads();
}

DI void delta_seq_unit(const Args& a, LAS float* sm, int unit) {
    const int tid = threadIdx.x, j = tid & 127, qd = tid >> 7, lane = tid & 63, wid = tid >> 6;
    const bool prompt = unit < 64; const int uu = prompt ? unit : unit - 64, b = uu >> 3, h = uu & 7;
    const int T = prompt ? SEQ : 4; const size_t tok0 = prompt ? (size_t)b * SEQ : (size_t)MP + b * 4;
    const bf16_t* QKV = (const bf16_t*)(a.ws + W_Q); bf16_t* Z = (bf16_t*)(a.ws + W_Z);
    const float* betaA = (const float*)(a.ws + W_BETA); const float* glogA = (const float*)(a.ws + W_GLOG);
    float S[32];
    if (prompt) {
#pragma unroll
        for (int i = 0; i < 32; ++i) S[i] = 0.f;
    } else {
#pragma unroll
        for (int i = 0; i < 32; ++i) S[i] = a.st_ssm[(((size_t)b * 8 + h) * 128 + 32 * qd + i) * 128 + j];
    }
    const int part = tid >> 7, col = (part < 3 ? part : 0) * 1024 + h * 128 + j;
    float r0 = 0.f, r1 = 0.f, r2 = 0.f, cw0 = 0.f, cw1 = 0.f, cw2 = 0.f, cw3 = 0.f;
    if (tid < 384) { cw0 = a.convw[col]; cw1 = a.convw[3072 + col]; cw2 = a.convw[2 * 3072 + col]; cw3 = a.convw[3 * 3072 + col];
        if (!prompt) { r0 = a.st_conv[((size_t)b * 3 + 0) * 3072 + col]; r1 = a.st_conv[((size_t)b * 3 + 1) * 3072 + col]; r2 = a.st_conv[((size_t)b * 3 + 2) * 3072 + col]; } }
    const float dnw = a.dnw[j];
    const bf16_t* qp = QKV + tok0 * NQKV + col;
    float r3n = (tid < 384) ? bf2f(qp[0]) : 0.f;
    float betan = betaA[tok0 * 8 + h], gln = glogA[tok0 * 8 + h];
    float zn = (tid < 128) ? bf2f(Z[tok0 * DM + h * 128 + j]) : 0.f;
    for (int t = 0; t < T; ++t) {
        const size_t tok = tok0 + t;
        const float r3 = r3n, beta = betan, gl = gln, zc = zn;
        if (t + 1 < T) { if (tid < 384) r3n = bf2f(qp[(size_t)(t + 1) * NQKV]); betan = betaA[(tok + 1) * 8 + h]; gln = glogA[(tok + 1) * 8 + h]; if (tid < 128) zn = bf2f(Z[(tok + 1) * DM + h * 128 + j]); }
        if (tid < 384) {
            const float acc = r0 * cw0 + r1 * cw1 + r2 * cw2 + r3 * cw3; r0 = r1; r1 = r2; r2 = r3;
            const float val = siluf_(acc); sm[tid] = val;
            const float ss = wave_sum(val * val); if (lane == 0) sm[384 + wid] = ss;
        }
        __syncthreads();
        const float nq = rsqrtf(sm[384] + sm[385] + 1e-6f) * 0.08838834764831845f, nk = rsqrtf(sm[386] + sm[387] + 1e-6f);
        const float g = __expf(gl);
        float d = 0.f;
#pragma unroll
        for (int i = 0; i < 32; ++i) d += S[i] * sm[128 + 32 * qd + i];
        sm[400 + qd * 128 + j] = d * nk;
        __syncthreads();
        const float dt = sm[400 + j] + sm[528 + j] + sm[656 + j] + sm[784 + j];
        const float vn = beta * (sm[256 + j] - g * dt);
        float o = 0.f;
#pragma unroll
        for (int i = 0; i < 32; ++i) { const float kk = sm[128 + 32 * qd + i] * nk; S[i] = g * S[i] + kk * vn; o += S[i] * sm[32 * qd + i]; }
        sm[1024 + qd * 128 + j] = o * nq;
        __syncthreads();
        float ot = 0.f;
        if (tid < 128) { ot = sm[1024 + j] + sm[1152 + j] + sm[1280 + j] + sm[1408 + j]; const float ss = wave_sum(ot * ot); if (lane == 0) sm[392 + wid] = ss; }
        __syncthreads();
        if (tid < 128) { const float ms = (sm[392] + sm[393]) * (1.0f / 128.0f);
            Z[tok * DM + h * 128 + j] = f2bf(ot * rsqrtf(ms + 1e-6f) * dnw * zc); }
    }
    float* so = a.out + (prompt ? O_SSMP : O_SSMS) + ((size_t)b * 8 + h) * 128 * 128;
#pragma unroll
    for (int i = 0; i < 32; ++i) so[(size_t)(32 * qd + i) * 128 + j] = S[i];
    __syncthreads();
}
DI void phase_delta_seq(const Args& a, LAS unsigned char* lds) {
    for (int unit = blockIdx.x; unit < 64 + 1024; unit += gridDim.x) delta_seq_unit(a, (LAS float*)lds, unit);
}


typedef short s16x4 __attribute__((ext_vector_type(4)));
DI bf16x8 pack8(float a0, float a1, float a2, float a3, float a4, float a5, float a6, float a7) {
    const u32x4 p = {cvt2(a0, a1), cvt2(a2, a3), cvt2(a4, a5), cvt2(a6, a7)}; return __builtin_bit_cast(bf16x8, p); }
template <int S_> DI bf16x8 pack_step(const f32x16& x) { return pack8(x[8 * S_], x[8 * S_ + 1], x[8 * S_ + 2], x[8 * S_ + 3], x[8 * S_ + 4], x[8 * S_ + 5], x[8 * S_ + 6], x[8 * S_ + 7]); }
#define MFMA32(a, b, c) __builtin_amdgcn_mfma_f32_32x32x16_bf16((a), (b), (c), 0, 0, 0)
constexpr size_t W_QKM = W_UP1, W_SIDE = W_UP1 + (size_t)2048 * 3072 * 2, W_TM = W_IN;
static_assert(W_SIDE + (size_t)256 * 3 * NQKV * 2 <= W_IN, "side buffer must fit behind QKm");

template <int PART> DI void conv_vals(const LAS bf16_t* rawt, const LAS float* cwl, int r, int ch, float (&acc)[8]) {
#pragma unroll
    for (int j = 0; j < 8; ++j) acc[j] = 0.f;
#pragma unroll
    for (int i = 0; i < 4; ++i) {
        const u32x4 raw = *(const LAS u32x4*)(rawt + (r + i) * 136 + ch);
        const f32x4 w0 = *(const LAS f32x4*)(cwl + ((PART * 4 + i) * 128 + ch)), w1 = *(const LAS f32x4*)(cwl + ((PART * 4 + i) * 128 + ch + 4));
        acc[0] += bflo(raw.x) * w0[0]; acc[1] += bfhi(raw.x) * w0[1]; acc[2] += bflo(raw.y) * w0[2]; acc[3] += bfhi(raw.y) * w0[3];
        acc[4] += bflo(raw.z) * w1[0]; acc[5] += bfhi(raw.z) * w1[1]; acc[6] += bflo(raw.w) * w1[2]; acc[7] += bfhi(raw.w) * w1[3];
    }
#pragma unroll
    for (int j = 0; j < 8; ++j) acc[j] = siluf_(acc[j]);
}
template <int PART> DI void conv_block(bf16_t* qb, const bf16_t* sb, LAS bf16_t* rawt, const LAS float* cwl, bool first, int h, int mb, int lane, bf16x8 (&frag)[8], bool dry) {
    const int r = lane & 31, hh = lane >> 5, tl = 32 * mb + r, colb = PART * 1024 + h * 128;
#pragma unroll
    for (int it = 0; it < 9; ++it) { const int p = lane + 64 * it, rr = p >> 4, seg = p & 15, tr = 32 * mb - 3 + rr;
        if (p < 560) { u32x4 v = {0u, 0u, 0u, 0u};
            if (tr >= 0) v = *(const u32x4*)(qb + (tr * NQKV + colb + seg * 8));
            else if (!first) v = *(const u32x4*)(sb + ((tr + 3) * NQKV + colb + seg * 8));
            *(LAS u32x4*)(rawt + rr * 136 + seg * 8) = v; } }
    float sc = 1.0f;
    if (PART < 2) {
        float ss = 0.f;
#pragma unroll 2
        for (int ks = 0; ks < 8; ++ks) { float acc[8]; conv_vals<PART>(rawt, cwl, r, 8 * hh + 16 * ks, acc);
#pragma unroll
            for (int j = 0; j < 8; ++j) ss += acc[j] * acc[j]; }
        ss += __shfl_xor(ss, 32, 64); sc = rsqrtf(ss + 1e-6f) * (PART == 0 ? 0.08838834764831845f : 1.0f);
    }
#pragma unroll
    for (int ks = 0; ks < 8; ++ks) {
        float acc[8]; conv_vals<PART>(rawt, cwl, r, 8 * hh + 16 * ks, acc);
        frag[ks] = pack8(acc[0] * sc, acc[1] * sc, acc[2] * sc, acc[3] * sc, acc[4] * sc, acc[5] * sc, acc[6] * sc, acc[7] * sc);
        if (!dry) *(bf16x8*)(qb + (tl * NQKV + colb + 8 * hh + 16 * ks)) = frag[ks];
        if ((ks & 1) == 1) asm volatile("" ::: "memory");
    }
}
DI void phase_delta_pre(const Args& a, LAS unsigned char* lds, bool dry) {
    bf16_t* QKV = (bf16_t*)(a.ws + W_Q); const bf16_t* side = (const bf16_t*)(a.ws + W_SIDE);
    float* glogA = (float*)(a.ws + W_GLOG); const float* betaA = (const float*)(a.ws + W_BETA);
    bf16_t* Tg = (bf16_t*)(a.ws + W_TM); bf16_t* Qg = (bf16_t*)(a.ws + W_QKM);
    const int tid = threadIdx.x, wid = tid >> 6;
    LAS float* Aw0 = (LAS float*)lds + wid * 4096; LAS float* vG0 = (LAS float*)(lds + 131072) + wid * 128; LAS float* cwl = (LAS float*)(lds + 135168);
#pragma unroll 1
    for (int inst = blockIdx.x * 8 + wid; inst < 2048; inst += gridDim.x * 8) {
        int lane = tid & 63; asm volatile("" : "+v"(lane));
        const int r = lane & 31, hh = lane >> 5;
        LAS float* Aw = Aw0; LAS float* vG = vG0; LAS float* vB = vG + 64;
        const int b = inst >> 8, h = (inst >> 5) & 7, c = inst & 31; const size_t tok0 = (size_t)b * SEQ + c * 64;
        __syncthreads();
        for (int e = tid; e < 1536; e += 512) cwl[e] = a.convw[(e >> 7) % 4 * NQKV + (e >> 9) * 1024 + h * 128 + (e & 127)];
        __syncthreads();
        float G = glogA[(tok0 + lane) * 8 + h];
#pragma unroll
        for (int o = 1; o < 64; o <<= 1) { const float t = __shfl_up(G, o, 64); if (lane >= o) G += t; }
        if (!dry) glogA[(tok0 + lane) * 8 + h] = G;
        vG[lane] = G; vB[lane] = betaA[(tok0 + lane) * 8 + h];
        const bool first = (c == 0); bf16_t* qb = QKV + tok0 * NQKV; const bf16_t* sb = side + ((size_t)b * 32 + c) * 3 * NQKV;
        bf16x8 fq[2][8], fk[2][8];
        { bf16x8 fv[8]; conv_block<2>(qb, sb, (LAS bf16_t*)Aw, cwl, first, h, 1, lane, fv, dry); conv_block<2>(qb, sb, (LAS bf16_t*)Aw, cwl, first, h, 0, lane, fv, dry); }
        conv_block<1>(qb, sb, (LAS bf16_t*)Aw, cwl, first, h, 1, lane, fk[1], dry); conv_block<1>(qb, sb, (LAS bf16_t*)Aw, cwl, first, h, 0, lane, fk[0], dry);
        conv_block<0>(qb, sb, (LAS bf16_t*)Aw, cwl, first, h, 1, lane, fq[1], dry); conv_block<0>(qb, sb, (LAS bf16_t*)Aw, cwl, first, h, 0, lane, fq[0], dry);
        f32x16 g00, g10, g11;
#pragma unroll
        for (int i = 0; i < 16; ++i) { g00[i] = 0.f; g10[i] = 0.f; g11[i] = 0.f; }
#pragma unroll
        for (int ks = 0; ks < 8; ++ks) { g00 = MFMA32(fk[0][ks], fk[0][ks], g00); g10 = MFMA32(fk[1][ks], fk[0][ks], g10); g11 = MFMA32(fk[1][ks], fk[1][ks], g11); }
#pragma unroll
        for (int ii = 0; ii < 16; ++ii) {
            const int i0 = crow(ii, hh), i1 = 32 + i0;
            const float G0 = vG[i0], G1 = vG[i1], B0 = vB[i0], B1 = vB[i1], Gr0 = vG[r], Gr1 = vG[32 + r];
            Aw[i0 * 64 + r] = (r < i0) ? B0 * g00[ii] * __expf(G0 - Gr0) : 0.f;
            Aw[i1 * 64 + r] = B1 * g10[ii] * __expf(G1 - Gr0);
            Aw[i1 * 64 + 32 + r] = (r < i0) ? B1 * g11[ii] * __expf(G1 - Gr1) : 0.f;
        }
#pragma unroll
        for (int i = 0; i < 16; ++i) { g00[i] = 0.f; g10[i] = 0.f; g11[i] = 0.f; }
#pragma unroll
        for (int ks = 0; ks < 8; ++ks) { g00 = MFMA32(fq[0][ks], fk[0][ks], g00); g10 = MFMA32(fq[1][ks], fk[0][ks], g10); g11 = MFMA32(fq[1][ks], fk[1][ks], g11); }
        bf16_t* qo = Qg + (size_t)inst * 3072;
#pragma unroll
        for (int ii = 0; ii < 16; ++ii) {
            const int i0 = crow(ii, hh), i1 = 32 + i0;
            const float G0 = vG[i0], G1 = vG[i1], Gr0 = vG[r], Gr1 = vG[32 + r];
            if (!dry) qo[i0 * 32 + r] = f2bf((r <= i0) ? g00[ii] * __expf(G0 - Gr0) : 0.f);
            if (!dry) qo[1024 + i0 * 32 + r] = f2bf(g10[ii] * __expf(G1 - Gr0));
            if (!dry) qo[2048 + i0 * 32 + r] = f2bf((r <= i0) ? g11[ii] * __expf(G1 - Gr1) : 0.f);
        }
#pragma unroll 1
        for (int i = 0; i < 64; i += 2) {
            const LAS float* ar = Aw + i * 64; const LAS float* br = ar + 64;
            float a0 = (lane == i) ? 1.f : 0.f, a1 = 0.f, b0 = (lane == i + 1) ? 1.f : 0.f, b1 = 0.f; int j = 0;
#pragma unroll 2
            for (; j + 4 <= i; j += 4) { const f32x4 a4 = *(const LAS f32x4*)(ar + j), b4 = *(const LAS f32x4*)(br + j);
                const float t0 = Aw[j * 64 + lane], t1 = Aw[(j + 1) * 64 + lane], t2 = Aw[(j + 2) * 64 + lane], t3 = Aw[(j + 3) * 64 + lane];
                a0 -= a4[0] * t0; b0 -= b4[0] * t0; a1 -= a4[1] * t1; b1 -= b4[1] * t1; a0 -= a4[2] * t2; b0 -= b4[2] * t2; a1 -= a4[3] * t3; b1 -= b4[3] * t3; }
            if (j < i) { const float t0 = Aw[j * 64 + lane], t1 = Aw[(j + 1) * 64 + lane];
                a0 -= ar[j] * t0; b0 -= br[j] * t0; a1 -= ar[j + 1] * t1; b1 -= br[j + 1] * t1; }
            const float xi = a0 + a1, ci = br[i], xj = (b0 + b1) - ci * xi;
            Aw[i * 64 + lane] = xi; Aw[(i + 1) * 64 + lane] = xj;
        }
        bf16_t* to = Tg + (size_t)inst * 3072;
#pragma unroll 4
        for (int i = 0; i < 32; ++i) {
            if (lane < 32 && !dry) to[i * 32 + lane] = f2bf(Aw[i * 64 + lane]);
            if (!dry) to[(lane < 32 ? 1024 : 2048) + i * 32 + (lane & 31)] = f2bf(Aw[(32 + i) * 64 + lane]);
        }
    }
}

DI bf16x8 lds_frag(const LAS bf16_t* p) { const u32x2 lo = *(const LAS u32x2*)p, hi = *(const LAS u32x2*)(p + 8); const u32x4 v = {lo.x, lo.y, hi.x, hi.y}; return __builtin_bit_cast(bf16x8, v); }
DI bf16x8 lds_frag_tr(const LAS bf16_t* lo_p) {
    const s16x4 lo = __builtin_amdgcn_ds_read_tr16_b64_v4i16((LAS s16x4*)lo_p), hi = __builtin_amdgcn_ds_read_tr16_b64_v4i16((LAS s16x4*)(lo_p + 8 * 136));
    return __builtin_shufflevector(lo, hi, 0, 1, 2, 3, 4, 5, 6, 7); }
DI void delta_scan_unit(const Args& a, LAS unsigned char* lds, int unit) {
    const int tid0 = threadIdx.x, wid = tid0 >> 6, b = unit >> 3, h = unit & 7, dv0 = 32 * (wid & 3);
    LAS bf16_t* KN = (LAS bf16_t*)lds; LAS bf16_t* QN = (LAS bf16_t*)(lds + 17408); LAS bf16_t* VC = (LAS bf16_t*)(lds + 34816);
    LAS bf16_t* TI = (LAS bf16_t*)(lds + 52224); LAS bf16_t* QI = (LAS bf16_t*)(lds + 61440); LAS float* OT0 = (LAS float*)(lds + 70656); LAS float* VE = (LAS float*)(lds + 138240);
    const bf16_t* QKV = (const bf16_t*)(a.ws + W_Q); const bf16_t* Tg = (const bf16_t*)(a.ws + W_TM); const bf16_t* Qg = (const bf16_t*)(a.ws + W_QKM);
    const float* Gc = (const float*)(a.ws + W_GLOG); const float* betaA = (const float*)(a.ws + W_BETA); bf16_t* Z = (bf16_t*)(a.ws + W_Z);
    f32x16 S[4];
#pragma unroll
    for (int d = 0; d < 4; ++d)
#pragma unroll
        for (int i = 0; i < 16; ++i) S[d][i] = 0.f;
#define NORMALIZE(cc, OTn, lt, zz) do { const size_t tokn = (size_t)b * SEQ + (cc) * 64; const int nrow = (lt) >> 2, nseg = (lt) & 3; \
        bf16_t* zp = Z + (tokn + nrow) * DM + h * 128 + nseg * 32; const LAS float* op = (OTn) + nrow * 132 + nseg * 32; \
        f32x4 ov[8]; float ss = 0.f; \
        _Pragma("unroll") for (int i = 0; i < 8; ++i) { ov[i] = *(const LAS f32x4*)(op + 4 * i); ss += ov[i][0] * ov[i][0] + ov[i][1] * ov[i][1] + ov[i][2] * ov[i][2] + ov[i][3] * ov[i][3]; } \
        ss += __shfl_xor(ss, 1, 64); ss += __shfl_xor(ss, 2, 64); \
        const float sc = rsqrtf(ss * (1.0f / 128.0f) + 1e-6f); \
        _Pragma("unroll") for (int i = 0; i < 4; ++i) { const f32x4 d0 = *(const f32x4*)(a.dnw + nseg * 32 + 8 * i), d1 = *(const f32x4*)(a.dnw + nseg * 32 + 8 * i + 4); const f32x4 o0 = ov[2 * i], o1 = ov[2 * i + 1]; u32x4 w; \
            w.x = cvt2(o0[0] * sc * d0[0] * bflo(zz[i].x), o0[1] * sc * d0[1] * bfhi(zz[i].x)); w.y = cvt2(o0[2] * sc * d0[2] * bflo(zz[i].y), o0[3] * sc * d0[3] * bfhi(zz[i].y)); \
            w.z = cvt2(o1[0] * sc * d1[0] * bflo(zz[i].z), o1[1] * sc * d1[1] * bfhi(zz[i].z)); w.w = cvt2(o1[2] * sc * d1[2] * bflo(zz[i].w), o1[3] * sc * d1[3] * bfhi(zz[i].w)); \
            *(u32x4*)(zp + 8 * i) = w; } } while (0)
    const bool computer = __builtin_amdgcn_readfirstlane(wid) < 4;
#pragma unroll 1
    for (int c = -1; c < 32; ++c) {
        int tid = tid0; asm volatile("" : "+v"(tid));
        const int lane = tid & 63, r = lane & 31, hh = lane >> 5;
        LAS float* OTc = OT0 + (c & 1) * 8448;
        __syncthreads();
        if (computer) {
            if (c >= 0) {
            f32x16 ks[2];
#pragma unroll
            for (int m = 0; m < 2; ++m)
#pragma unroll
                for (int i = 0; i < 16; ++i) ks[m][i] = 0.f;
#pragma unroll
            for (int d = 0; d < 4; ++d) { const bf16x8 sb0 = pack_step<0>(S[d]), sb1 = pack_step<1>(S[d]);
#pragma unroll
                for (int m = 0; m < 2; ++m) { const int off = (32 * m + r) * 136 + 32 * d + 4 * hh;
                    ks[m] = MFMA32(lds_frag(KN + off), sb0, ks[m]); ks[m] = MFMA32(lds_frag(KN + off + 16), sb1, ks[m]); } }
            f32x16 rhs[2];
#pragma unroll
            for (int m = 0; m < 2; ++m)
#pragma unroll
                for (int g4 = 0; g4 < 4; ++g4) { const int rb0 = 32 * m + 8 * g4 + 4 * hh;
                    const f32x4 bt4 = *(const LAS f32x4*)(VE + 64 + rb0), eg4 = *(const LAS f32x4*)(VE + rb0);
                    const s16x4 v4 = __builtin_amdgcn_ds_read_tr16_b64_v4i16((LAS s16x4*)(VC + (rb0 + ((lane & 15) >> 2)) * 136 + dv0 + 16 * ((lane >> 4) & 1) + 4 * (lane & 3)));
#pragma unroll
                    for (int jj = 0; jj < 4; ++jj) rhs[m][4 * g4 + jj] = bt4[jj] * (bf2f((bf16_t)v4[jj]) - eg4[jj] * ks[m][4 * g4 + jj]); }
            bf16x8 Rb[2][2]; Rb[0][0] = pack_step<0>(rhs[0]); Rb[0][1] = pack_step<1>(rhs[0]); Rb[1][0] = pack_step<0>(rhs[1]); Rb[1][1] = pack_step<1>(rhs[1]);
            f32x16 vn[2];
#pragma unroll
            for (int i = 0; i < 16; ++i) { vn[0][i] = 0.f; vn[1][i] = 0.f; }
#pragma unroll
            for (int s = 0; s < 2; ++s) vn[0] = MFMA32(lds_frag(TI + r * 72 + 16 * s + 4 * hh), Rb[0][s], vn[0]);
#pragma unroll
            for (int m = 0; m < 2; ++m)
#pragma unroll
                for (int s = 0; s < 2; ++s) vn[1] = MFMA32(lds_frag(TI + (32 + r) * 72 + 32 * m + 16 * s + 4 * hh), Rb[m][s], vn[1]);
            bf16x8 Vb[2][2]; Vb[0][0] = pack_step<0>(vn[0]); Vb[0][1] = pack_step<1>(vn[0]); Vb[1][0] = pack_step<0>(vn[1]); Vb[1][1] = pack_step<1>(vn[1]);
            f32x16 qs[2];
#pragma unroll
            for (int m = 0; m < 2; ++m)
#pragma unroll
                for (int i = 0; i < 16; ++i) qs[m][i] = 0.f;
#pragma unroll
            for (int d = 0; d < 4; ++d) { const bf16x8 sb0 = pack_step<0>(S[d]), sb1 = pack_step<1>(S[d]);
#pragma unroll
                for (int m = 0; m < 2; ++m) { const int off = (32 * m + r) * 136 + 32 * d + 4 * hh;
                    qs[m] = MFMA32(lds_frag(QN + off), sb0, qs[m]); qs[m] = MFMA32(lds_frag(QN + off + 16), sb1, qs[m]); } }
            f32x16 o[2];
#pragma unroll
            for (int i = 0; i < 16; ++i) { o[0][i] = 0.f; o[1][i] = 0.f; }
#pragma unroll
            for (int s = 0; s < 2; ++s) o[0] = MFMA32(lds_frag(QI + r * 72 + 16 * s + 4 * hh), Vb[0][s], o[0]);
#pragma unroll
            for (int m = 0; m < 2; ++m)
#pragma unroll
                for (int s = 0; s < 2; ++s) o[1] = MFMA32(lds_frag(QI + (32 + r) * 72 + 32 * m + 16 * s + 4 * hh), Vb[m][s], o[1]);
#pragma unroll
            for (int m = 0; m < 2; ++m)
#pragma unroll
                for (int g4 = 0; g4 < 4; ++g4) { const int rb0 = 32 * m + 8 * g4 + 4 * hh; const f32x4 eg4 = *(const LAS f32x4*)(VE + rb0);
#pragma unroll
                    for (int jj = 0; jj < 4; ++jj) OTc[(rb0 + jj) * 132 + dv0 + r] = o[m][4 * g4 + jj] + eg4[jj] * qs[m][4 * g4 + jj]; }
            f32x16 wv[2];
#pragma unroll
            for (int m = 0; m < 2; ++m)
#pragma unroll
                for (int g4 = 0; g4 < 4; ++g4) { const f32x4 ed4 = *(const LAS f32x4*)(VE + 128 + 32 * m + 8 * g4 + 4 * hh);
#pragma unroll
                    for (int jj = 0; jj < 4; ++jj) wv[m][4 * g4 + jj] = vn[m][4 * g4 + jj] * ed4[jj]; }
            bf16x8 Wb[2][2]; Wb[0][0] = pack_step<0>(wv[0]); Wb[0][1] = pack_step<1>(wv[0]); Wb[1][0] = pack_step<0>(wv[1]); Wb[1][1] = pack_step<1>(wv[1]);
            const float eL = VE[63];
            const int i16 = lane & 15, blk = (lane >> 4) & 1, tq = i16 >> 2, tp = i16 & 3;
#pragma unroll
            for (int d = 0; d < 4; ++d) {
#pragma unroll
                for (int i = 0; i < 16; ++i) S[d][i] *= eL;
#pragma unroll
                for (int m = 0; m < 2; ++m)
#pragma unroll
                    for (int s = 0; s < 2; ++s)
                        S[d] = MFMA32(lds_frag_tr(KN + (32 * m + 16 * s + 4 * hh + tq) * 136 + 32 * d + 16 * blk + 4 * tp), Wb[m][s], S[d]);
            }
            }
            __syncthreads();
        } else {
            u32x4 pf[15], zz[4]; float pG = 0.f, pGL = 0.f, pB = 0.f;
            const int ltv = tid - 256, cn = c + 1 < 32 ? c + 1 : 31;
            { const int cp = c > 0 ? c - 1 : 0; const bf16_t* zq = Z + ((size_t)b * SEQ + cp * 64 + (ltv >> 2)) * DM + h * 128 + (ltv & 3) * 32;
#pragma unroll
              for (int i = 0; i < 4; ++i) zz[i] = *(const u32x4*)(zq + 8 * i); }
            const size_t tok1 = (size_t)b * SEQ + cn * 64; const size_t inst = ((size_t)b * 8 + h) * 32 + cn;
            const bf16_t* qb = QKV + tok1 * NQKV + h * 128; const bf16_t* tb = Tg + inst * 3072; const bf16_t* qg = Qg + inst * 3072;
#pragma unroll
            for (int i = 0; i < 12; ++i) { const int p = ltv + 256 * i, part = p >> 10, row = (p & 1023) >> 4, seg = p & 15; pf[i] = *(const u32x4*)(qb + (row * NQKV + part * 1024 + seg * 8)); }
#pragma unroll
            for (int i = 0; i < 3; ++i) { const int p = ltv + 256 * i, m = p >= 384, q = m ? p - 384 : p; pf[12 + i] = *(const u32x4*)((m ? qg : tb) + q * 8); }
            if (ltv < 64) { pG = Gc[(tok1 + ltv) * 8 + h]; pGL = Gc[(tok1 + 63) * 8 + h]; pB = betaA[(tok1 + ltv) * 8 + h]; }
            if (c > 0) NORMALIZE(c - 1, OT0 + ((c - 1) & 1) * 8448, ltv, zz);
            __syncthreads();
            if (c + 1 < 32) {
#pragma unroll
                for (int i = 0; i < 12; ++i) { const int p = ltv + 256 * i, part = p >> 10, row = (p & 1023) >> 4, seg = p & 15;
                    *(LAS u32x4*)((part == 0 ? QN : (part == 1 ? KN : VC)) + row * 136 + seg * 8) = pf[i]; }
#pragma unroll
                for (int i = 0; i < 3; ++i) { const int p = ltv + 256 * i, m = p >= 384, q = m ? p - 384 : p, blk = q >> 7, rr = (q & 127) >> 2, c8 = (q & 3) * 8;
                    *(LAS u32x4*)((m ? QI : TI) + (32 * (blk > 0) + rr) * 72 + 32 * (blk == 2) + c8) = pf[12 + i]; }
                if (ltv < 64) { VE[ltv] = __expf(pG); VE[64 + ltv] = pB; VE[128 + ltv] = __expf(pGL - pG); }
            }
        }
    }
    __syncthreads();
    int tidf = tid0; asm volatile("" : "+v"(tidf));
    if (!computer) { u32x4 zz[4]; const int ltf = tidf - 256; const bf16_t* zq = Z + ((size_t)b * SEQ + 31 * 64 + (ltf >> 2)) * DM + h * 128 + (ltf & 3) * 32;
#pragma unroll
        for (int i = 0; i < 4; ++i) zz[i] = *(const u32x4*)(zq + 8 * i);
        NORMALIZE(31, OT0 + 8448, ltf, zz); }
#undef NORMALIZE
    const int lane = tidf & 63, r = lane & 31, hh = lane >> 5;
    if (wid < 4) { float* so = a.out + O_SSMP + ((size_t)b * 8 + h) * 128 * 128;
#pragma unroll
        for (int d = 0; d < 4; ++d)
#pragma unroll
            for (int ii = 0; ii < 16; ++ii) so[(size_t)(32 * d + crow(ii, hh)) * 128 + dv0 + r] = S[d][ii]; }
    __syncthreads();
}

DI void delta_sample2(const Args& a, LAS float* sm, int pair) {
    const int tid = threadIdx.x, j = tid & 127, qd = tid >> 7, lane = tid & 63, wid = tid >> 6, b = pair >> 2, h0 = (pair & 3) * 2;
    const size_t tok0 = (size_t)MP + b * 4;
    const bf16_t* QKV = (const bf16_t*)(a.ws + W_Q); bf16_t* Z = (bf16_t*)(a.ws + W_Z);
    const float* betaA = (const float*)(a.ws + W_BETA); const float* glogA = (const float*)(a.ws + W_GLOG);
    float S[2][32], r0[2], r1[2], r2[2], cw[2][4], r3n[2], betan[2], gln[2], zn[2];
    const int part = tid >> 7, pc = (part < 3 ? part : 0) * 1024 + j;
#pragma unroll
    for (int u = 0; u < 2; ++u) { const int h = h0 + u, col = pc + h * 128;
        const float* sp = a.st_ssm + (((size_t)b * 8 + h) * 128 + 32 * qd) * 128;
#pragma unroll
        for (int i = 0; i < 32; ++i) S[u][i] = sp[i * 128 + j];
        r0[u] = r1[u] = r2[u] = 0.f; r3n[u] = 0.f; zn[u] = 0.f;
#pragma unroll
        for (int i = 0; i < 4; ++i) cw[u][i] = 0.f;
        if (tid < 384) {
#pragma unroll
            for (int i = 0; i < 4; ++i) cw[u][i] = a.convw[i * NQKV + col];
            r0[u] = a.st_conv[((size_t)b * 3 + 0) * NQKV + col]; r1[u] = a.st_conv[((size_t)b * 3 + 1) * NQKV + col]; r2[u] = a.st_conv[((size_t)b * 3 + 2) * NQKV + col];
            r3n[u] = bf2f(QKV[tok0 * NQKV + col]); }
        betan[u] = betaA[tok0 * 8 + h]; gln[u] = glogA[tok0 * 8 + h];
        if (tid < 128) zn[u] = bf2f(Z[tok0 * DM + h * 128 + j]); }
    const float dnw = a.dnw[j];
#pragma unroll 1
    for (int t = 0; t < 4; ++t) {
        const size_t tok = tok0 + t; float r3[2], beta[2], gl[2], zc[2];
#pragma unroll
        for (int u = 0; u < 2; ++u) { const int h = h0 + u; r3[u] = r3n[u]; beta[u] = betan[u]; gl[u] = gln[u]; zc[u] = zn[u];
            if (t < 3) { if (tid < 384) r3n[u] = bf2f(QKV[(tok + 1) * NQKV + pc + h * 128]); betan[u] = betaA[(tok + 1) * 8 + h]; gln[u] = glogA[(tok + 1) * 8 + h]; if (tid < 128) zn[u] = bf2f(Z[(tok + 1) * DM + h * 128 + j]); } }
        if (tid < 384) {
#pragma unroll
            for (int u = 0; u < 2; ++u) { const float acc = r0[u] * cw[u][0] + r1[u] * cw[u][1] + r2[u] * cw[u][2] + r3[u] * cw[u][3]; r0[u] = r1[u]; r1[u] = r2[u]; r2[u] = r3[u];
                const float val = siluf_(acc); sm[u * 1536 + tid] = val; const float ss = wave_sum(val * val); if (lane == 0) sm[u * 1536 + 384 + wid] = ss; }
        }
        __syncthreads();
        float nq[2], nk[2], g[2];
#pragma unroll
        for (int u = 0; u < 2; ++u) { LAS float* su = sm + u * 1536;
            nq[u] = rsqrtf(su[384] + su[385] + 1e-6f) * 0.08838834764831845f; nk[u] = rsqrtf(su[386] + su[387] + 1e-6f); g[u] = __expf(gl[u]);
            float d = 0.f;
#pragma unroll
            for (int i = 0; i < 32; ++i) d += S[u][i] * su[128 + 32 * qd + i];
            su[400 + qd * 128 + j] = d * nk[u]; }
        __syncthreads();
#pragma unroll
        for (int u = 0; u < 2; ++u) { LAS float* su = sm + u * 1536;
            const float dt = su[400 + j] + su[528 + j] + su[656 + j] + su[784 + j];
            const float vn = beta[u] * (su[256 + j] - g[u] * dt) * nk[u];
            float o = 0.f;
#pragma unroll
            for (int i = 0; i < 32; ++i) { S[u][i] = g[u] * S[u][i] + su[128 + 32 * qd + i] * vn; o += S[u][i] * su[32 * qd + i]; }
            su[1024 + qd * 128 + j] = o * nq[u]; }
        __syncthreads();
        float ot[2] = {0.f, 0.f};
        if (tid < 128) {
#pragma unroll
            for (int u = 0; u < 2; ++u) { LAS float* su = sm + u * 1536; ot[u] = su[1024 + j] + su[1152 + j] + su[1280 + j] + su[1408 + j]; const float ss = wave_sum(ot[u] * ot[u]); if (lane == 0) su[392 + wid] = ss; } }
        __syncthreads();
        if (tid < 128) {
#pragma unroll
            for (int u = 0; u < 2; ++u) { LAS float* su = sm + u * 1536; const float ms = (su[392] + su[393]) * (1.0f / 128.0f);
                Z[tok * DM + (h0 + u) * 128 + j] = f2bf(ot[u] * rsqrtf(ms + 1e-6f) * dnw * zc[u]); } }
    }
#pragma unroll
    for (int u = 0; u < 2; ++u) { float* so = a.out + O_SSMS + (((size_t)b * 8 + h0 + u) * 128 + 32 * qd) * 128;
#pragma unroll
        for (int i = 0; i < 32; ++i) so[i * 128 + j] = S[u][i]; }
    __syncthreads();
}
DI void phase_delta_scan(const Args& a, LAS unsigned char* lds) {
    const int G = (int)gridDim.x, bi = (int)blockIdx.x, nscan = G > 64 ? 64 : 0;
    if (bi < nscan) { delta_scan_unit(a, lds, bi); return; }
    if (nscan == 0) {
#pragma unroll 1
        for (int u = bi; u < 64; u += G) delta_scan_unit(a, lds, u);
    }
#pragma unroll 1
    for (int pair = bi - nscan; pair < 512; pair += G - nscan) delta_sample2(a, (LAS float*)lds, pair);
    { pg8::Gemm g{(const bf16_t*)(a.ws + W_U), (const bf16_t*)(a.ws + W_BA), MT, DM, DM, DM}; pg8::StaticOrder S; S.init(MT, DM, G - nscan, bi - nscan);
      pg8::gemm_phase<EpiM1, pg8::StaticOrder>(lds, g, S, EpiM1{(bf16_t*)(a.out + O_Y)}); }
}

#define XB_TMO      128
#define XB_XCNT(j)  (256  + 64 * (j))
#define XB_XSUB(j)  (1280 + 64 * (j))
#define XB_XGEN(j)  (2304 + 64 * (j))
#define XB_TOP      3328
#define XB_TOPGEN   3392
#define XCD_BAR_WORDS 3456
#define XB_SPIN_CAP (1u << 18)

__device__ __forceinline__ unsigned xb_ld(unsigned* p)              { return __hip_atomic_load(p, __ATOMIC_RELAXED, __HIP_MEMORY_SCOPE_AGENT); }
__device__ __forceinline__ unsigned xb_add(unsigned* p, unsigned v) { return __hip_atomic_fetch_add(p, v, __ATOMIC_RELAXED, __HIP_MEMORY_SCOPE_AGENT); }
__device__ __forceinline__ unsigned xb_xcc_id() { return (unsigned)__builtin_amdgcn_s_getreg((3 << 11) | 20) & 0xFu; }
#define XB_SPIN(cond, bar) do { unsigned _sp = 0; while (cond) { __builtin_amdgcn_s_sleep(1); \
    if ((++_sp & 255u) == 0u) { if (xb_ld(&(bar)[XB_TMO])) break; if (_sp > XB_SPIN_CAP) { atomicAdd(&(bar)[XB_TMO], 1u); break; } } } } while (0)

struct XcdBarrier {
    unsigned* bar; unsigned x;
    volatile LAS unsigned* st;
};

__device__ __forceinline__ XcdBarrier xcd_barrier_post(unsigned* bar, volatile LAS unsigned* st) {
    XcdBarrier b; b.bar = bar; b.x = xb_xcc_id(); b.st = st;
    if (threadIdx.x == 0) (void)xb_add(&bar[XB_XCNT(b.x)], 1u);
    return b;
}
__device__ __forceinline__ void xcd_barrier_complete(unsigned* bar, unsigned x, unsigned& nloc, unsigned& nx) {
    const unsigned G = gridDim.x * gridDim.y * gridDim.z;
    unsigned sum, cnt, mine, sp = 0u;
    for (;;) {
        sum = 0u; cnt = 0u; mine = 0u;
#pragma unroll
        for (unsigned j = 0; j < 16; ++j) { const unsigned c = xb_ld(&bar[XB_XCNT(j)]); sum += c; cnt += (c > 0u) ? 1u : 0u; mine = (j == x) ? c : mine; }
        if (sum == G) break;
        __builtin_amdgcn_s_sleep(1);
        if ((++sp & 255u) == 0u) { if (xb_ld(&bar[XB_TMO])) break; if (sp > XB_SPIN_CAP) { atomicAdd(&bar[XB_TMO], 1u); break; } }
    }
    nloc = mine > 0u ? mine : 1u; nx = cnt > 0u ? cnt : 1u;
}

__device__ __forceinline__ void xcd_barrier(const XcdBarrier& b) {
    asm volatile("s_waitcnt vmcnt(0)" ::: "memory");
    __syncthreads();
    if (threadIdx.x == 0) {
        unsigned* bar = b.bar;
        __builtin_amdgcn_s_waitcnt(0);
        unsigned nloc = b.st[0], nx = b.st[1];
        if (nloc == 0u) { xcd_barrier_complete(bar, b.x, nloc, nx); b.st[0] = nloc; b.st[1] = nx; }
        const unsigned old = xb_add(&bar[XB_XSUB(b.x)], 1u);
        const unsigned gen = old / nloc;
        if (old + 1u == (gen + 1u) * nloc) {
            __builtin_amdgcn_fence(__ATOMIC_RELEASE, "agent");
            asm volatile("s_waitcnt vmcnt(0)" ::: "memory");
            const unsigned og = xb_add(&bar[XB_TOP], 1u);
            const unsigned tg = og / nx;
            if (og + 1u == (tg + 1u) * nx) xb_add(&bar[XB_TOPGEN], 1u);
            else XB_SPIN(xb_ld(&bar[XB_TOPGEN]) == tg, bar);
            __builtin_amdgcn_fence(__ATOMIC_ACQUIRE, "agent");
            xb_add(&bar[XB_XGEN(b.x)], 1u);
            asm volatile("s_waitcnt vmcnt(0)" ::: "memory");
        } else {
            XB_SPIN(xb_ld(&bar[XB_XGEN(b.x)]) == gen, bar);
            __builtin_amdgcn_fence(__ATOMIC_ACQUIRE, "agent");
            asm volatile("s_waitcnt vmcnt(0)" ::: "memory");
        }
    }
    __syncthreads();
}


typedef const __attribute__((address_space(4))) Args* KArgs;
#if defined(__HIP_DEVICE_COMPILE__)
#define LOAD_ARGS KArgs kp = (KArgs)__builtin_amdgcn_kernarg_segment_ptr(); asm volatile("" : "+s"(kp)); const Args a = *kp;
#else
#define LOAD_ARGS const Args a = a_;
#endif
#ifndef DUP_MASK
#define DUP_MASK 0
#endif
#define PHASE(n, ...) if (ph_lo <= (n) && (n) < ph_hi) for (int rep_ = 0; rep_ < (((DUP_MASK >> (n)) & 1) ? 2 : 1); ++rep_) { if ((n) > ph_lo || rep_) xcd_barrier(xb); LOAD_ARGS \
    unsigned char* ws = a.ws; float* out = a.out; (void)ws; (void)out; \
    bf16_t* XB = (bf16_t*)(ws + W_XB); bf16_t* Hh = (bf16_t*)(ws + W_Q); bf16_t* Uu = (bf16_t*)(ws + W_U); bf16_t* Zz = (bf16_t*)(ws + W_Z); \
    bf16_t* Gt = (bf16_t*)(out + O_Y); bf16_t* Vv = (bf16_t*)(out + O_SSMS); bf16_t* Mm = (bf16_t*)(ws + W_Q); float* M1 = (float*)(ws + W_M1); \
    (void)XB; (void)Hh; (void)Uu; (void)Zz; (void)Gt; (void)Vv; (void)Mm; (void)M1; __VA_ARGS__ }
__global__ void __launch_bounds__(512, 2) mk_fwd(Args a_) {
    extern __shared__ __attribute__((aligned(16))) unsigned char shm[];
    LAS unsigned char* lds = (LAS unsigned char*)shm;
    const int ph_lo = a_.ph_lo, ph_hi = a_.ph_hi;
    volatile LAS unsigned* xst = (volatile LAS unsigned*)(lds + 141312);
    if (threadIdx.x == 0) { xst[0] = 0u; xst[1] = 0u; }
    __syncthreads();
    const XcdBarrier xb = xcd_barrier_post((unsigned*)(a_.ws + W_BAR), xst);
    if (ph_hi == 12345) cg::this_grid().sync();
    PHASE(0, phase_convert(a, lds);)
    PHASE(1, run_gemm(lds, XB, (const bf16_t*)(ws + W_UP1), 2 * DFF, DM, EpiSwiglu{Hh});)
    PHASE(2, run_gemm_res(lds, Hh, (const bf16_t*)(ws + W_DN1), DFF, EpiRes<0>{out + O_Y, a.x_p, a.x_s, nullptr, 0.5f}, out + O_SSMS);)
    PHASE(3, phase_ln(out + O_Y, a.ln1g, a.ln1b, XB, out + O_SSMS, DFF / 256, 0.5f, a.x_s, nullptr);)
    PHASE(4, run_gemm(lds, XB, (const bf16_t*)(ws + W_IN), NIN, DM, EpiProj{Uu, Vv, (bf16_t*)(ws + W_Q), Zz, Gt, (bf16_t*)(ws + W_SIDE), (float*)(ws + W_BETA), (float*)(ws + W_GLOG), out + O_CONVP, out + O_CONVS, (float*)(ws + W_STAT),
                                                                      (const float*)(ws + W_BIN), a.alog, a.dtb});)
    PHASE(5, { const bool dry = ((DUP_MASK >> 5) & 1) && rep_ == 0; if (!dry || (DUP_MASK & (1 << 20))) phase_delta_pre(a, lds, dry); if (!dry || (DUP_MASK & (1 << 21))) phase_mix(a, lds, dry); })
    PHASE(6, phase_delta_scan(a, lds);)
    PHASE(7, run_gemm(lds, Zz, (const bf16_t*)(ws + W_BB), DM, DM, EpiM2{Gt, Mm});)
    PHASE(8, run_gemm_res(lds, Mm, (const bf16_t*)(ws + W_WO), DM, EpiRes<1>{out + O_Y, nullptr, nullptr, XB, 1.0f}, (float*)Uu);)
    PHASE(9, phase_ln(out + O_Y, a.ln2g, a.ln2b, XB, (const float*)Uu, DM / 256, 1.0f, nullptr, XB);)
    PHASE(10, run_gemm(lds, XB, (const bf16_t*)(ws + W_UP2), 2 * DFF, DM, EpiSwiglu{Hh});)
    PHASE(11, run_gemm_res(lds, Hh, (const bf16_t*)(ws + W_DN2), DFF, EpiRes<1>{out + O_Y, nullptr, nullptr, XB, 0.5f}, (float*)Uu);)
    PHASE(12, phase_ln(out + O_Y, a.ln3g, a.ln3b, nullptr, (const float*)Uu, DFF / 256, 0.5f, nullptr, XB);)
}

extern "C" void kernel_launch(void* const* d_in, const int* in_sizes, int n_in, void* d_out, int out_size, void* d_ws, size_t ws_size, hipStream_t stream) {
    static int grid = 0;
    if (grid == 0) {
        if (n_in != 27 || (size_t)out_size != O_END || ws_size < W_END) { fprintf(stderr, "kernel_launch: unexpected sizes n_in %d out %d ws %zu (need %zu)\n", n_in, out_size, ws_size, (size_t)W_END); grid = -1; return; }
        int dev = 0, cus = 0, per_cu = 0;
        (void)hipGetDevice(&dev); (void)hipDeviceGetAttribute(&cus, hipDeviceAttributeMultiprocessorCount, dev);
        if (hipFuncSetAttribute((const void*)mk_fwd, hipFuncAttributeMaxDynamicSharedMemorySize, LDS_BYTES) != hipSuccess) { fprintf(stderr, "kernel_launch: hipFuncSetAttribute failed\n"); grid = -1; return; }
        (void)hipOccupancyMaxActiveBlocksPerMultiprocessor(&per_cu, (const void*)mk_fwd, 512, LDS_BYTES);
        if (per_cu < 1) { fprintf(stderr, "kernel_launch: occupancy query gave %d\n", per_cu); per_cu = 1; }
        (void)hipGetLastError();
        grid = cus * 1;
    }
    if (grid < 0) return;
    if (hipMemsetAsync((char*)d_ws + W_BAR, 0, 16384, stream) != hipSuccess) { fprintf(stderr, "kernel_launch: memset of barrier words failed\n"); return; }
    Args a{};
    const float** f = (const float**)&a;
    for (int i = 0; i < 27; ++i) f[i] = (const float*)d_in[i];
    a.out = (float*)d_out; a.ws = (unsigned char*)d_ws;
#if MK_ONE_LAUNCH
    a.ph_lo = 0; a.ph_hi = 13;
    void* args[] = {&a};
    hipError_t e = hipLaunchCooperativeKernel((const void*)mk_fwd, dim3(grid), dim3(512), args, LDS_BYTES, stream);
    if (e != hipSuccess) fprintf(stderr, "cooperative launch failed: %s (grid %d)\n", hipGetErrorString(e), grid);
#else
    for (int ph = 0; ph < 13; ++ph) { a.ph_lo = ph; a.ph_hi = ph + 1; hipLaunchKernelGGL(mk_fwd, dim3(grid), dim3(512), LDS_BYTES, stream, a); }
#endif
}
```

```cpp
#define MK_ONE_LAUNCH 1
#include <hip/hip_runtime.h>
#include <hip/hip_cooperative_groups.h>
#include <cstdio>
namespace cg = cooperative_groups;
namespace pg8 {
#define PG8_LAS __attribute__((address_space(3)))
typedef unsigned short bf16_t;
typedef short bf16x8 __attribute__((ext_vector_type(8)));
typedef float f32x4 __attribute__((ext_vector_type(4)));
typedef unsigned u32x4 __attribute__((ext_vector_type(4)));
constexpr int BM = 256, BK = 64, HALF = 128, HTB = HALF * BK * 2  , STAGE_BYTES = 8 * HTB, NXCD = 8, WGM = 8;

__host__ __device__ __forceinline__ int lds_byte(int r, int c) { const int st = (r >> 4) * 2 + (c >> 5), rr = r & 15, cc = c & 31, ob = rr * 64 + cc * 2; return st * 1024 + (ob ^ (((ob >> 9) & 1) << 5)); }
__host__ __device__ __forceinline__ void stage_rc(int b, int& R, int& C) { const int st = b / 1024, sb = b % 1024, swz = sb ^ (((sb >> 9) & 1) << 5); R = (st >> 1) * 16 + swz / 64; C = (st & 1) * 32 + (swz % 64) / 2; }
__host__ __device__ __forceinline__ int perm32(int rho) { const int n = rho >> 4, i = rho & 15; return 8 * (i >> 2) + 4 * n + (i & 3); }
struct Unit { int pm, pn, kb; };
struct Gemm { const bf16_t* A; const bf16_t* Bt; int M, N, K, KL; };
struct StaticOrder {
    int nM, nN, nwg, G, c;
    __host__ __device__ void init(int M, int N, int G_, int c_) { nM = M / BM; nN = N / BM; nwg = nM * nN; G = G_; c = c_; }
    __host__ __device__ bool next(int i, Unit& u) const {
        const long L = (long)i * G + c; if (L >= nwg) return false;
        int wgid = (int)L; { const int q = nwg / NXCD, r = nwg % NXCD, xcd = wgid % NXCD, off = wgid / NXCD; wgid = (xcd < r ? xcd * (q + 1) : r * (q + 1) + (xcd - r) * q) + off; }
        const int nig = WGM * nN, gid = wgid / nig, fm = gid * WGM, gsz = (nM - fm) < WGM ? (nM - fm) : WGM;
        u.pm = fm + ((wgid % nig) % gsz); u.pn = (wgid % nig) / gsz; u.kb = 0; return true;
    }
    __device__ __forceinline__ void a_ready(const Unit&) const {}
    __device__ __forceinline__ void done(const Unit&) const {}
};
__device__ __forceinline__ unsigned cvt_pk_bf16(float lo, float hi) { unsigned r; asm volatile("v_cvt_pk_bf16_f32 %0, %1, %2" : "=v"(r) : "v"(lo), "v"(hi)); return r; }
template <class Epi, class Sched>
__device__ __forceinline__ void gemm_phase(PG8_LAS unsigned char* lds, const Gemm g, const Sched& S, const Epi& E) {
    const int tid = threadIdx.x, wid = __builtin_amdgcn_readfirstlane(tid >> 6), lane = tid & 63, wr = wid >> 2, wc = wid & 3, fr = lane & 15, fq = lane >> 4;
    const int K = g.K, nt = g.KL / BK;
    unsigned voffA[2], voffB[2];
#pragma unroll
    for (int i = 0; i < 2; ++i) { int R, C; stage_rc(tid * 16 + i * 8192, R, C); const int Rb = Epi::PERM ? ((R & ~31) + perm32(R & 31)) : R;
        voffA[i] = (unsigned)(R * K + C) * 2u; voffB[i] = (unsigned)(Rb * K + C) * 2u; }
    const size_t kstep = (size_t)(BK * 2);
    const size_t hstep = (size_t)HALF * K * 2;
    const size_t tstep = 2 * hstep;
    const unsigned ldsw = (unsigned)wid * 1024u;
    const int aoff = lds_byte(wr * 64 + fr, fq * 8), boff = lds_byte(wc * 32 + fr, fq * 8);
#define PG8_SA(b, h) (((b) * 2 + (h)) * HTB)
#define PG8_SB(b, h) ((4 + (b) * 2 + (h)) * HTB)
#define PG8_STAGE(bufoff, gbase, voff) do { _Pragma("unroll") for (int _i = 0; _i < 2; ++_i) \
        __builtin_amdgcn_global_load_lds((const unsigned*)((const char*)(gbase) + (voff)[_i]), (PG8_LAS unsigned*)(lds + (bufoff) + ldsw + _i * 8192), 16, 0, 0); } while (0)
#define PG8_LDA(dst, b, h) do { _Pragma("unroll") for (int m = 0; m < 4; ++m) _Pragma("unroll") for (int k = 0; k < 2; ++k) dst[m][k] = *(const PG8_LAS bf16x8*)(lds + PG8_SA(b, h) + aoff + m * 2048 + k * 1024); } while (0)
#define PG8_LDB(dst, b, h) do { _Pragma("unroll") for (int n = 0; n < 2; ++n) _Pragma("unroll") for (int k = 0; k < 2; ++k) dst[n][k] = *(const PG8_LAS bf16x8*)(lds + PG8_SB(b, h) + boff + n * 2048 + k * 1024); } while (0)
#define PG8_MMA(ai, bj, At, Bt) do { __builtin_amdgcn_s_setprio(1); _Pragma("unroll") for (int m = 0; m < 4; ++m) _Pragma("unroll") for (int n = 0; n < 2; ++n) _Pragma("unroll") for (int k = 0; k < 2; ++k) \
        acc[ai][bj][m][n] = __builtin_amdgcn_mfma_f32_16x16x32_bf16(Bt[n][k], At[m][k], acc[ai][bj][m][n], 0, 0, 0); __builtin_amdgcn_s_setprio(0); } while (0)
#define PG8_WAIT_V(n) asm volatile("s_waitcnt vmcnt(" #n ")" ::: "memory")
#define PG8_WAIT_L(n) asm volatile("s_waitcnt lgkmcnt(" #n ")" ::: "memory")
#define PG8_BAR __builtin_amdgcn_s_barrier()
#define PG8_SCHED __builtin_amdgcn_sched_barrier(0)
    Unit cur, nxt; int ui = 0;
    if (!S.next(0, cur)) return;
    f32x4 acc[2][2][4][2];
#pragma unroll
    for (int a = 0; a < 2; ++a)
#pragma unroll
        for (int b = 0; b < 2; ++b)
#pragma unroll
            for (int m = 0; m < 4; ++m)
#pragma unroll
                for (int n = 0; n < 2; ++n) acc[a][b][m][n] = (f32x4){0.f, 0.f, 0.f, 0.f};
    bf16x8 At[4][2], B0[2][2], B1[2][2];
    const char* cA = (const char*)g.A + (size_t)cur.pm * tstep + cur.kb; const char* cB = (const char*)g.Bt + (size_t)cur.pn * tstep + cur.kb;
    S.a_ready(cur);
    PG8_STAGE(PG8_SB(0, 0), cB, voffB); PG8_STAGE(PG8_SA(0, 0), cA, voffA); PG8_STAGE(PG8_SB(0, 1), cB + hstep, voffB); PG8_STAGE(PG8_SA(0, 1), cA + hstep, voffA);
    if (wr == 1) PG8_BAR;
    PG8_WAIT_V(4); PG8_BAR;
    PG8_STAGE(PG8_SB(1, 0), cB + kstep, voffB); PG8_STAGE(PG8_SA(1, 0), cA + kstep, voffA); PG8_STAGE(PG8_SB(1, 1), cB + hstep + kstep, voffB);
    PG8_WAIT_V(6); PG8_BAR;
    for (;;) {
        const bool has_next = S.next(ui + 1, nxt);
        const char* nA = has_next ? (const char*)g.A + (size_t)nxt.pm * tstep + nxt.kb : cA; const char* nB = has_next ? (const char*)g.Bt + (size_t)nxt.pn * tstep + nxt.kb : cB;
        for (int t = 0; t < nt; t += 2) {
            const bool last = (t == nt - 2);
            const char* a1 = cA + (size_t)(t + 1) * kstep;
            const char* a2 = last ? nA : cA + (size_t)(t + 2) * kstep; const char* b2 = last ? nB : cB + (size_t)(t + 2) * kstep;
            const char* a3 = a2 + kstep; const char* b3 = b2 + kstep;
            if (last && has_next) S.a_ready(nxt);
            PG8_LDB(B0, 0, 0); PG8_SCHED; PG8_LDA(At, 0, 0); PG8_STAGE(PG8_SA(1, 1), a1 + hstep, voffA);
            PG8_WAIT_L(8); PG8_BAR; PG8_WAIT_L(0); PG8_MMA(0, 0, At, B0); PG8_BAR; PG8_SCHED;
            PG8_LDB(B1, 0, 1); PG8_STAGE(PG8_SB(0, 0), b2, voffB);
            PG8_BAR; PG8_WAIT_L(0); PG8_MMA(0, 1, At, B1); PG8_BAR;
            PG8_LDA(At, 0, 1); PG8_STAGE(PG8_SA(0, 0), a2, voffA);
            PG8_BAR; PG8_WAIT_L(0); PG8_MMA(1, 0, At, B0); PG8_BAR; PG8_SCHED;
            PG8_STAGE(PG8_SB(0, 1), b2 + hstep, voffB);
            PG8_WAIT_V(6); PG8_BAR; PG8_MMA(1, 1, At, B1); PG8_BAR;
            PG8_LDB(B0, 1, 0); PG8_SCHED; PG8_LDA(At, 1, 0); PG8_STAGE(PG8_SA(0, 1), a2 + hstep, voffA);
            PG8_WAIT_L(8); PG8_BAR; PG8_WAIT_L(0); PG8_MMA(0, 0, At, B0); PG8_BAR; PG8_SCHED;
            PG8_LDB(B1, 1, 1); PG8_STAGE(PG8_SB(1, 0), b3, voffB);
            PG8_BAR; PG8_WAIT_L(0); PG8_MMA(0, 1, At, B1); PG8_BAR;
            PG8_LDA(At, 1, 1); PG8_STAGE(PG8_SA(1, 0), a3, voffA);
            PG8_BAR; PG8_WAIT_L(0); PG8_MMA(1, 0, At, B0); PG8_BAR; PG8_SCHED;
            PG8_STAGE(PG8_SB(1, 1), b3 + hstep, voffB);
            PG8_WAIT_V(6); PG8_BAR; PG8_MMA(1, 1, At, B1); PG8_BAR;
        }
        if constexpr (!Epi::AFTER_DRAIN) { E(acc, cur, wr, wc, fr, fq); S.done(cur); }
        if (!has_next) break;
#pragma unroll
        for (int a = 0; a < 2; ++a)
#pragma unroll
            for (int b = 0; b < 2; ++b)
#pragma unroll
                for (int m = 0; m < 4; ++m)
#pragma unroll
                    for (int n = 0; n < 2; ++n) acc[a][b][m][n] = (f32x4){0.f, 0.f, 0.f, 0.f};
        cur = nxt; cA = nA; cB = nB; ++ui;
    }
    PG8_WAIT_V(0);
    if (wr == 0) PG8_BAR;
    PG8_BAR;
    if constexpr (Epi::AFTER_DRAIN) { E.fused(acc, cur, wr, wc, fr, fq, lds, wid, lane); S.done(cur); }
#undef PG8_SA
#undef PG8_SB
#undef PG8_STAGE
#undef PG8_LDA
#undef PG8_LDB
#undef PG8_MMA
#undef PG8_WAIT_V
#undef PG8_WAIT_L
#undef PG8_BAR
#undef PG8_SCHED
}
}
using pg8::bf16_t; using pg8::bf16x8; using pg8::f32x4; using pg8::u32x4;
#define LAS __attribute__((address_space(3)))
typedef float f32x16 __attribute__((ext_vector_type(16)));
typedef unsigned u32x2 __attribute__((ext_vector_type(2)));
#define DI __device__ __forceinline__

constexpr int DM = 1024, MP = 16384, MS = 512, MT = MP + MS, SEQ = 2048, DFF = 2816, NIN = 8448, NQKV = 3072;
constexpr float ALPHA = 1.189207115002721f;
constexpr size_t O_Y = 0, O_CONVP = (size_t)MT * DM, O_SSMP = O_CONVP + 8 * 3 * 3072, O_CONVS = O_SSMP + (size_t)8 * 8 * 128 * 128,
                 O_SSMS = O_CONVS + (size_t)128 * 3 * 3072, O_GMV = O_SSMS + (size_t)128 * 8 * 128 * 128, O_END = O_GMV + (size_t)MS * DM;
constexpr size_t W_UP1 = 0, W_DN1 = W_UP1 + (size_t)2 * DFF * DM * 2, W_IN = W_DN1 + (size_t)DM * DFF * 2, W_BA = W_IN + (size_t)NIN * DM * 2,
                 W_BB = W_BA + (size_t)DM * DM * 2, W_WO = W_BB + (size_t)DM * DM * 2, W_UP2 = W_WO + (size_t)DM * DM * 2, W_DN2 = W_UP2 + (size_t)2 * DFF * DM * 2,
                 W_BIN = W_DN2 + (size_t)DM * DFF * 2, W_BETA = W_BIN + (size_t)NIN * 4, W_GLOG = W_BETA + (size_t)MT * 8 * 4, W_XB = W_GLOG + (size_t)MT * 8 * 4,
                 W_U = W_XB + (size_t)MT * DM * 2, W_Z = W_U + (size_t)MT * DM * 2, W_Q = W_Z + (size_t)MT * DM * 2, W_M1 = W_Q + (size_t)MT * DM * 2,
                 W_STAT = W_Q + (size_t)MT * NQKV * 2, W_BAR = W_STAT + (size_t)MT * 2 * 4, W_END = W_BAR + 16384;
constexpr int LDS_BYTES = pg8::STAGE_BYTES + 12288;

struct Args {
    const float *x_p, *x_s, *st_conv, *st_ssm, *up1, *dn1, *ln1g, *ln1b, *w_in, *b_in, *gmvg, *gmvb, *gmws, *gmbs, *convw, *alog, *dtb, *dnw, *wba, *wbb, *wo, *ln2g, *ln2b, *up2, *dn2, *ln3g, *ln3b;
    float* out; unsigned char* ws; int ph_lo, ph_hi;
};

DI bf16_t f2bf(float x) { unsigned u = __float_as_uint(x); u += 0x7fffu + ((u >> 16) & 1u); return (bf16_t)(u >> 16); }
DI float bf2f(bf16_t b) { return __uint_as_float(((unsigned)b) << 16); }
DI float bflo(unsigned w) { return __uint_as_float(w << 16); }
DI float bfhi(unsigned w) { return __uint_as_float(w & 0xffff0000u); }
DI unsigned pk2(float lo, float hi) { return (unsigned)f2bf(lo) | ((unsigned)f2bf(hi) << 16); }
typedef __bf16 bf2_t __attribute__((ext_vector_type(2)));
typedef float f32x2 __attribute__((ext_vector_type(2)));
DI unsigned cvt2(float lo, float hi) { const f32x2 v = {lo, hi}; return __builtin_bit_cast(unsigned, __builtin_convertvector(v, bf2_t)); }
DI float sigmoidf_(float x) { return __builtin_amdgcn_rcpf(1.0f + __builtin_amdgcn_exp2f(-1.4426950408889634f * x)); }
DI float siluf_(float x) { return x * sigmoidf_(x); }
DI float gelu_tanh(float x) { const float u = 0.7978845608028654f * (x + 0.044715f * x * x * x); return x * sigmoidf_(2.0f * u); }
DI float softplusf_(float x) { return fmaxf(x, 0.f) + log1pf(__expf(-fabsf(x))); }
DI float wave_sum(float v) {
#pragma unroll
    for (int o = 32; o > 0; o >>= 1) v += __shfl_xor(v, o, 64);
    return v;
}

DI int src_col16(int mode, int n16) {
    if (mode == 0) return n16;
    if (mode == 1) { const int tile = n16 >> 8, within = n16 & 255; return (within >> 7) * DFF + tile * 128 + (within & 127); }
    if (n16 < 6144) return n16;
    if (n16 < 8192) return n16 + 16;
    if (n16 < 8208) return n16 - 8192 + 6144;
    return -1;
}
DI void convert_weight(const float* __restrict__ src, int K, int ld, bf16_t* __restrict__ dst, int Nd, int mode, LAS bf16_t* tile, int bi, int G) {
    const int tid = threadIdx.x, tk = K / 64, ntiles = (Nd / 64) * tk, krow = tid >> 3, cseg = tid & 7;
    f32x4 pa = {0.f, 0.f, 0.f, 0.f}, pb = pa;
    auto fetch = [&](int t) { const int n0 = (t / tk) * 64, k0 = (t % tk) * 64; const int sc = src_col16(mode, n0 + (cseg >> 1) * 16);
        pa = (f32x4){0.f, 0.f, 0.f, 0.f}; pb = pa;
        if (sc >= 0) { const float* p = src + (size_t)(k0 + krow) * ld + sc + (cseg & 1) * 8; pa = *(const f32x4*)p; pb = *(const f32x4*)(p + 4); } };
    if (bi < ntiles) fetch(bi);
    for (int t = bi; t < ntiles; t += G) {
        const int n0 = (t / tk) * 64, k0 = (t % tk) * 64;
        const f32x4 a = pa, b = pb;
        if (t + G < ntiles) fetch(t + G);
#pragma unroll
        for (int i = 0; i < 4; ++i) { tile[(cseg * 8 + i) * 72 + krow] = f2bf(a[i]); tile[(cseg * 8 + 4 + i) * 72 + krow] = f2bf(b[i]); }
        __syncthreads();
        { const int nl = tid >> 3, ks = tid & 7; const u32x4 v = *(const LAS u32x4*)(tile + nl * 72 + ks * 8);
          *(u32x4*)(dst + (size_t)(n0 + nl) * K + k0 + ks * 8) = v; }
        __syncthreads();
    }
}
DI void phase_convert(const Args& a, LAS unsigned char* lds) {
    LAS bf16_t* tile = (LAS bf16_t*)lds;
    unsigned char* ws = a.ws;
    const int bi = (int)blockIdx.x, G = (int)gridDim.x;
    convert_weight(a.up1, DM, 2 * DFF, (bf16_t*)(ws + W_UP1), 2 * DFF, 1, tile, bi, G);
    convert_weight(a.dn1, DFF, DM, (bf16_t*)(ws + W_DN1), DM, 0, tile, bi, G);
    {
        convert_weight(a.w_in, DM, 8208, (bf16_t*)(ws + W_IN), NIN, 2, tile, bi, G);
        convert_weight(a.up2, DM, 2 * DFF, (bf16_t*)(ws + W_UP2), 2 * DFF, 1, tile, bi, G);
        convert_weight(a.dn2, DFF, DM, (bf16_t*)(ws + W_DN2), DM, 0, tile, bi, G); }
    convert_weight(a.wba, DM, DM, (bf16_t*)(ws + W_BA), DM, 0, tile, bi, G);
    convert_weight(a.wbb, DM, DM, (bf16_t*)(ws + W_BB), DM, 0, tile, bi, G);
    convert_weight(a.wo, DM, DM, (bf16_t*)(ws + W_WO), DM, 0, tile, bi, G);
    const size_t gt = (size_t)blockIdx.x * blockDim.x + threadIdx.x, gn = (size_t)gridDim.x * blockDim.x;
    float* binr = (float*)(ws + W_BIN);
    for (size_t i = gt; i < (size_t)NIN; i += gn) { const int sc = src_col16(2, (int)i & ~15); binr[i] = sc >= 0 ? a.b_in[sc + ((int)i & 15)] : 0.f; }
    float* stat = (float*)(ws + W_STAT);
    for (size_t i = gt; i < (size_t)MT * 2; i += gn) stat[i] = 0.f;
    bf16_t* xb = (bf16_t*)(ws + W_XB);
    for (size_t i0 = gt; i0 < (size_t)MT * DM / 8; i0 += 4 * gn) {
        f32x4 v0[4], v1[4];
#pragma unroll
        for (int k = 0; k < 4; ++k) { const size_t i = i0 + k * gn; if (i < (size_t)MT * DM / 8) { const size_t e = i * 8; const float* p = e < (size_t)MP * DM ? a.x_p + e : a.x_s + (e - (size_t)MP * DM);
            v0[k] = *(const f32x4*)p; v1[k] = *(const f32x4*)(p + 4); } }
#pragma unroll
        for (int k = 0; k < 4; ++k) { const size_t i = i0 + k * gn; if (i < (size_t)MT * DM / 8) {
            u32x4 w; w.x = cvt2(v0[k][0], v0[k][1]); w.y = cvt2(v0[k][2], v0[k][3]); w.z = cvt2(v1[k][0], v1[k][1]); w.w = cvt2(v1[k][2], v1[k][3]);
            *(u32x4*)(xb + i * 8) = w; } }
    }
}

struct EpiSwiglu {
    static constexpr bool PERM = true, AFTER_DRAIN = false;
    bf16_t* H;
    DI void operator()(const f32x4 (&acc)[2][2][4][2], const pg8::Unit& u, int wr, int wc, int fr, int fq) const {
        const int row0 = u.pm * 256 + wr * 64 + fr, h0 = u.pn * 128 + wc * 32 + 8 * fq;
#pragma unroll
        for (int ai = 0; ai < 2; ++ai)
#pragma unroll
            for (int m = 0; m < 4; ++m) { bf16_t* rowp = H + (size_t)(row0 + ai * 128 + m * 16) * DFF + h0;
                const f32x4 x0 = acc[ai][0][m][0], x1 = acc[ai][0][m][1], g0 = acc[ai][1][m][0], g1 = acc[ai][1][m][1];
                u32x4 w; w.x = cvt2(siluf_(x0[0]) * g0[0], siluf_(x0[1]) * g0[1]); w.y = cvt2(siluf_(x0[2]) * g0[2], siluf_(x0[3]) * g0[3]);
                w.z = cvt2(siluf_(x1[0]) * g1[0], siluf_(x1[1]) * g1[1]); w.w = cvt2(siluf_(x1[2]) * g1[2], siluf_(x1[3]) * g1[3]);
                *(u32x4*)rowp = w; }
    }
};
template <int RES  > struct EpiRes {
    static constexpr bool PERM = false, AFTER_DRAIN = false;
    bf16_t* R; const float* xp; const float* xs; const bf16_t* xb; float scale;
    DI void operator()(const f32x4 (&acc)[2][2][4][2], const pg8::Unit& u, int wr, int wc, int fr, int fq) const {
        const int row0 = u.pm * 256 + wr * 64 + fr, col0 = u.pn * 256 + wc * 32 + 4 * fq;
#pragma unroll
        for (int ai = 0; ai < 2; ++ai)
#pragma unroll
            for (int m = 0; m < 4; ++m) { const int row = row0 + ai * 128 + m * 16;
#pragma unroll
                for (int bj = 0; bj < 2; ++bj)
#pragma unroll
                    for (int n = 0; n < 2; ++n) { const int col = col0 + bj * 128 + n * 16; f32x4 r;
                        if (RES == 0) { const float* p = row < MP ? xp + (size_t)row * DM + col : xs + (size_t)(row - MP) * DM + col; r = *(const f32x4*)p; }
                        else { const u32x2 w = *(const u32x2*)(xb + (size_t)row * DM + col); r = (f32x4){bflo(w.x), bfhi(w.x), bflo(w.y), bfhi(w.y)}; }
                        const f32x4 y = r * ALPHA + acc[ai][bj][m][n] * scale; u32x2 o; o.x = cvt2(y[0], y[1]); o.y = cvt2(y[2], y[3]);
                        *(u32x2*)(R + (size_t)row * DM + col) = o; } }
    }
};
struct EpiProj {
    static constexpr bool PERM = true, AFTER_DRAIN = false;
    bf16_t *U, *V, *QKV, *Z, *G, *side; float *beta, *glog, *convp, *convs, *stat; const float *bias, *alog, *dtb;
    template <int MODE> DI void body(const f32x4 (&acc)[2][2][4][2], int pn, int row0, int wc, int fq) const {
#pragma unroll
        for (int bj = 0; bj < 2; ++bj) {
            const int col = pn * 256 + wc * 32 + 8 * fq + bj * 128;
            const f32x4 b0 = *(const f32x4*)(bias + col), b1 = *(const f32x4*)(bias + col + 4);
#pragma unroll
            for (int ai = 0; ai < 2; ++ai)
#pragma unroll
                for (int m = 0; m < 4; ++m) {
                    const int row = row0 + ai * 128 + m * 16;
                    f32x4 v0 = acc[ai][bj][m][0] + b0, v1 = acc[ai][bj][m][1] + b1;
                    if (MODE == 5) {
                        const int c = col - 8192;
                        if (c == 0) { f32x4 o0, o1;
#pragma unroll
                            for (int j = 0; j < 4; ++j) { o0[j] = sigmoidf_(v0[j]); o1[j] = sigmoidf_(v1[j]); }
                            *(f32x4*)(beta + (size_t)row * 8) = o0; *(f32x4*)(beta + (size_t)row * 8 + 4) = o1; }
                        if (c == 8) { f32x4 o0, o1;
#pragma unroll
                            for (int j = 0; j < 4; ++j) { o0[j] = -__expf(alog[j]) * softplusf_(v0[j] + dtb[j]); o1[j] = -__expf(alog[4 + j]) * softplusf_(v1[j] + dtb[4 + j]); }
                            *(f32x4*)(glog + (size_t)row * 8) = o0; *(f32x4*)(glog + (size_t)row * 8 + 4) = o1; }
                    } else {
                        bf16_t* dst;
                        if (MODE == 0 || MODE == 1) {
#pragma unroll
                            for (int j = 0; j < 4; ++j) { v0[j] = gelu_tanh(v0[j]); v1[j] = gelu_tanh(v1[j]); }
                            if (MODE == 1) {
                                float s = v0[0] + v0[1] + v0[2] + v0[3] + v1[0] + v1[1] + v1[2] + v1[3];
                                float q = v0[0] * v0[0] + v0[1] * v0[1] + v0[2] * v0[2] + v0[3] * v0[3] + v1[0] * v1[0] + v1[1] * v1[1] + v1[2] * v1[2] + v1[3] * v1[3];
                                s += __shfl_xor(s, 16, 64); q += __shfl_xor(q, 16, 64); s += __shfl_xor(s, 32, 64); q += __shfl_xor(q, 32, 64);
                                if (fq == 0) { atomicAdd(stat + (size_t)row * 2, s); atomicAdd(stat + (size_t)row * 2 + 1, q); } }
                            dst = (MODE == 0 ? U + (size_t)row * DM + col : V + (size_t)row * DM + (col - 1024));
                        } else if (MODE == 2) {
                            const int c = col - 2048; dst = QKV + (size_t)row * NQKV + c;
                            float* cp = nullptr;
                            if (row < MP) { const int t = row & (SEQ - 1); if (t >= SEQ - 3) cp = convp + ((size_t)(row >> 11) * 3 + (t - (SEQ - 3))) * NQKV + c; }
                            else { const int r = row - MP, t = r & 3; if (t >= 1) cp = convs + ((size_t)(r >> 2) * 3 + (t - 1)) * NQKV + c; }
                            if (cp) { *(f32x4*)cp = v0; *(f32x4*)(cp + 4) = v1; }
                            if (row < MP) { const int t6 = row & 63, nc = (row >> 6) + 1;
                                if (t6 >= 61 && (nc & 31) != 0) { u32x4 w; w.x = cvt2(v0[0], v0[1]); w.y = cvt2(v0[2], v0[3]); w.z = cvt2(v1[0], v1[1]); w.w = cvt2(v1[2], v1[3]);
                                    *(u32x4*)(side + ((size_t)nc * 3 + (t6 - 61)) * NQKV + c) = w; } }
                        } else if (MODE == 3) {
#pragma unroll
                            for (int j = 0; j < 4; ++j) { v0[j] = siluf_(v0[j]); v1[j] = siluf_(v1[j]); }
                            dst = Z + (size_t)row * DM + (col - 5120);
                        } else {
#pragma unroll
                            for (int j = 0; j < 4; ++j) { v0[j] = sigmoidf_(v0[j]); v1[j] = sigmoidf_(v1[j]); }
                            dst = G + (size_t)row * 2048 + (col - 6144);
                        }
                        u32x4 w; w.x = cvt2(v0[0], v0[1]); w.y = cvt2(v0[2], v0[3]); w.z = cvt2(v1[0], v1[1]); w.w = cvt2(v1[2], v1[3]);
                        *(u32x4*)dst = w;
                    }
                }
        }
    }
    DI void operator()(const f32x4 (&acc)[2][2][4][2], const pg8::Unit& u, int wr, int wc, int fr, int fq) const {
        const int row0 = u.pm * 256 + wr * 64 + fr, pn = u.pn;
        if (pn < 4) body<0>(acc, pn, row0, wc, fq);
        else if (pn < 8) body<1>(acc, pn, row0, wc, fq);
        else if (pn < 20) body<2>(acc, pn, row0, wc, fq);
        else if (pn < 24) body<3>(acc, pn, row0, wc, fq);
        else if (pn < 32) body<4>(acc, pn, row0, wc, fq);
        else body<5>(acc, pn, row0, wc, fq);
    }
};
struct EpiM1 {
    static constexpr bool PERM = false, AFTER_DRAIN = false;
    bf16_t* G;
    DI void operator()(const f32x4 (&acc)[2][2][4][2], const pg8::Unit& u, int wr, int wc, int fr, int fq) const {
        const int row0 = u.pm * 256 + wr * 64 + fr, col0 = u.pn * 256 + wc * 32 + 4 * fq;
#pragma unroll
        for (int ai = 0; ai < 2; ++ai)
#pragma unroll
            for (int m = 0; m < 4; ++m) { const int row = row0 + ai * 128 + m * 16;
#pragma unroll
                for (int bj = 0; bj < 2; ++bj)
#pragma unroll
                    for (int n = 0; n < 2; ++n) { const int col = col0 + bj * 128 + n * 16; bf16_t* p = G + (size_t)row * 2048 + col;
                        const u32x2 w = *(const u32x2*)p; const f32x4 v = (f32x4){bflo(w.x), bfhi(w.x), bflo(w.y), bfhi(w.y)} * acc[ai][bj][m][n];
                        u32x2 o; o.x = cvt2(v[0], v[1]); o.y = cvt2(v[2], v[3]); *(u32x2*)p = o; } asm volatile("" ::: "memory"); }
    }
};
struct EpiM2 {
    static constexpr bool PERM = false, AFTER_DRAIN = false;
    const bf16_t* G; bf16_t* Mm;
    DI void operator()(const f32x4 (&acc)[2][2][4][2], const pg8::Unit& u, int wr, int wc, int fr, int fq) const {
        const int row0 = u.pm * 256 + wr * 64 + fr, col0 = u.pn * 256 + wc * 32 + 4 * fq;
#pragma unroll
        for (int ai = 0; ai < 2; ++ai)
#pragma unroll
            for (int m = 0; m < 4; ++m) { const int row = row0 + ai * 128 + m * 16;
#pragma unroll
                for (int bj = 0; bj < 2; ++bj)
#pragma unroll
                    for (int n = 0; n < 2; ++n) { const int col = col0 + bj * 128 + n * 16; const bf16_t* p = G + (size_t)row * 2048 + col;
                        const u32x2 w1 = *(const u32x2*)p, w = *(const u32x2*)(p + 1024);
                        const f32x4 v = (f32x4){bflo(w1.x), bfhi(w1.x), bflo(w1.y), bfhi(w1.y)} + (f32x4){bflo(w.x), bfhi(w.x), bflo(w.y), bfhi(w.y)} * acc[ai][bj][m][n];
                        u32x2 o; o.x = cvt2(v[0], v[1]); o.y = cvt2(v[2], v[3]);
                        *(u32x2*)(Mm + (size_t)row * DM + col) = o; } asm volatile("" ::: "memory"); }
    }
};
template <class Epi> DI void run_gemm(LAS unsigned char* lds, const bf16_t* A, const bf16_t* Bt, int N, int K, const Epi& E) {
    pg8::Gemm g{A, Bt, MT, N, K, K}; pg8::StaticOrder S; S.init(MT, N, (int)gridDim.x, (int)blockIdx.x);
    pg8::gemm_phase<Epi, pg8::StaticOrder>(lds, g, S, E);
}
struct SplitOrder {
    int nsplit, nsub, G, c;
    DI void init(int K, int G_, int c_) { nsplit = K / 256; nsub = 8 * nsplit; G = G_; c = c_; }
    DI bool next(int i, pg8::Unit& u) const { const int s = i * G + c; if (s >= nsub) return false; const int tile = s / nsplit, ks = s - tile * nsplit; u.pm = MP / 256 + (tile >> 2); u.pn = tile & 3; u.kb = ks * 512; return true; }
    DI void a_ready(const pg8::Unit&) const {}
    DI void done(const pg8::Unit&) const {}
};
struct EpiPartial {
    static constexpr bool PERM = false, AFTER_DRAIN = false;
    float* P;
    DI void operator()(const f32x4 (&acc)[2][2][4][2], const pg8::Unit& u, int wr, int wc, int fr, int fq) const {
        const int row0 = (u.pm - MP / 256) * 256 + wr * 64 + fr, col0 = u.pn * 256 + wc * 32 + 4 * fq; float* base = P + (size_t)(u.kb >> 9) * MS * DM;
#pragma unroll
        for (int ai = 0; ai < 2; ++ai)
#pragma unroll
            for (int m = 0; m < 4; ++m) { float* rowp = base + (size_t)(row0 + ai * 128 + m * 16) * DM + col0;
#pragma unroll
                for (int bj = 0; bj < 2; ++bj)
#pragma unroll
                    for (int n = 0; n < 2; ++n) *(f32x4*)(rowp + bj * 128 + n * 16) = acc[ai][bj][m][n]; }
    }
};
template <class Epi> DI void run_gemm_res(LAS unsigned char* lds, const bf16_t* A, const bf16_t* Bt, int K, const Epi& E, float* P) {
    { pg8::Gemm g{A, Bt, MP, DM, K, K}; pg8::StaticOrder S; S.init(MP, DM, (int)gridDim.x, (int)blockIdx.x); pg8::gemm_phase<Epi, pg8::StaticOrder>(lds, g, S, E); }
    { pg8::Gemm g{A, Bt, MT, DM, K, 256}; SplitOrder S; S.init(K, (int)gridDim.x, (int)blockIdx.x); pg8::gemm_phase<EpiPartial, SplitOrder>(lds, g, S, EpiPartial{P}); }
}

DI void phase_ln(const bf16_t* __restrict__ Rb, float* __restrict__ yout, const float* __restrict__ g, const float* __restrict__ b, bf16_t* __restrict__ xb, const float* P, int nsplit, float scale, const float* xs, const bf16_t* resb) {
    const int lane = threadIdx.x & 63, wv = blockIdx.x * 8 + (threadIdx.x >> 6), nw = gridDim.x * 8;
    f32x4 gg[4], bb[4];
#pragma unroll
    for (int i = 0; i < 4; ++i) { gg[i] = *(const f32x4*)(g + 4 * lane + 256 * i); bb[i] = *(const f32x4*)(b + 4 * lane + 256 * i); }
    for (int row = wv; row < MT; row += nw) {
        f32x4 v[4]; float s = 0.f;
        if (row < MP) {
#pragma unroll
            for (int i = 0; i < 4; ++i) { const u32x2 w = *(const u32x2*)(Rb + (size_t)row * DM + 4 * lane + 256 * i); v[i] = (f32x4){bflo(w.x), bfhi(w.x), bflo(w.y), bfhi(w.y)}; }
        } else {
            const size_t ro = (size_t)(row - MP) * DM + 4 * lane;
#pragma unroll
            for (int i = 0; i < 4; ++i) { v[i] = (f32x4){0.f, 0.f, 0.f, 0.f};
                for (int k = 0; k < nsplit; ++k) v[i] += *(const f32x4*)(P + (size_t)k * MS * DM + ro + 256 * i);
                f32x4 r;
                if (xs) r = *(const f32x4*)(xs + ro + 256 * i);
                else { const u32x2 w = *(const u32x2*)(resb + (size_t)row * DM + 4 * lane + 256 * i); r = (f32x4){bflo(w.x), bfhi(w.x), bflo(w.y), bfhi(w.y)}; }
                v[i] = r * ALPHA + v[i] * scale; }
        }
#pragma unroll
        for (int i = 0; i < 4; ++i) s += v[i][0] + v[i][1] + v[i][2] + v[i][3];
        const float mu = wave_sum(s) * (1.0f / DM); float q = 0.f;
#pragma unroll
        for (int i = 0; i < 4; ++i) { v[i] -= mu; q += v[i][0] * v[i][0] + v[i][1] * v[i][1] + v[i][2] * v[i][2] + v[i][3] * v[i][3]; }
        const float rs = rsqrtf(wave_sum(q) * (1.0f / DM) + 1e-5f);
#pragma unroll
        for (int i = 0; i < 4; ++i) { const f32x4 y = v[i] * rs * gg[i] + bb[i];
            if (xb) { u32x2 w; w.x = pk2(y[0], y[1]); w.y = pk2(y[2], y[3]); *(u32x2*)(xb + (size_t)row * DM + 4 * lane + 256 * i) = w; }
            else *(f32x4*)(yout + (size_t)row * DM + 4 * lane + 256 * i) = y; }
    }
}
DI void phase_vnorm(bf16_t* __restrict__ V, const float* __restrict__ g, const float* __restrict__ b, float* __restrict__ gmv) {
    const int lane = threadIdx.x & 63, wv = blockIdx.x * 8 + (threadIdx.x >> 6), nw = gridDim.x * 8;
    for (int row = wv; row < MT; row += nw) {
        bf16_t* p = V + (size_t)row * DM + 8 * lane; float v[16]; float s = 0.f;
#pragma unroll
        for (int i = 0; i < 2; ++i) { const u32x4 w = *(const u32x4*)(p + 512 * i);
            v[8 * i + 0] = bflo(w.x); v[8 * i + 1] = bfhi(w.x); v[8 * i + 2] = bflo(w.y); v[8 * i + 3] = bfhi(w.y);
            v[8 * i + 4] = bflo(w.z); v[8 * i + 5] = bfhi(w.z); v[8 * i + 6] = bflo(w.w); v[8 * i + 7] = bfhi(w.w); }
#pragma unroll
        for (int i = 0; i < 16; ++i) s += v[i];
        const float mu = wave_sum(s) * (1.0f / DM); float q = 0.f;
#pragma unroll
        for (int i = 0; i < 16; ++i) { v[i] -= mu; q += v[i] * v[i]; }
        const float rs = rsqrtf(wave_sum(q) * (1.0f / DM) + 1e-5f);
#pragma unroll
        for (int i = 0; i < 2; ++i) { const int c = 8 * lane + 512 * i;
            const f32x4 g0 = *(const f32x4*)(g + c), g1 = *(const f32x4*)(g + c + 4), b0 = *(const f32x4*)(b + c), b1 = *(const f32x4*)(b + c + 4);
            f32x4 y0, y1;
#pragma unroll
            for (int j = 0; j < 4; ++j) { y0[j] = v[8 * i + j] * rs * g0[j] + b0[j]; y1[j] = v[8 * i + 4 + j] * rs * g1[j] + b1[j]; }
            u32x4 w; w.x = pk2(y0[0], y0[1]); w.y = pk2(y0[2], y0[3]); w.z = pk2(y1[0], y1[1]); w.w = pk2(y1[2], y1[3]);
            *(u32x4*)(p + 512 * i) = w;
            if (row >= MP) { float* o = gmv + (size_t)(row - MP) * DM + c; *(f32x4*)o = y0; *(f32x4*)(o + 4) = y1; } }
    }
}

DI int crow(int reg, int h) { return (reg & 3) + 8 * (reg >> 2) + 4 * h; }
DI void phase_mix(const Args& a, LAS unsigned char* lds, bool dry) {
    bf16_t* U = (bf16_t*)(a.ws + W_U); const bf16_t* V = (const bf16_t*)(a.out + O_SSMS); const float* stat = (const float*)(a.ws + W_STAT);
    LAS bf16_t* vt = (LAS bf16_t*)lds;
    const int tid0 = threadIdx.x;
#pragma unroll 1
    for (int tile = blockIdx.x; tile < 1024; tile += gridDim.x) {
        int tid = tid0; asm volatile("" : "+v"(tid));
        const int lane = tid & 63, wid = tid >> 6, r = lane & 31, h = lane >> 5, rb = wid >> 1, ch = wid & 1;
        const int g = tile & 7, bc = tile >> 3; const size_t tok0 = (size_t)bc * 128;
        const int t = 32 * rb + r; const float* wrow = a.gmws + ((size_t)g * 128 + t) * 128;
        __syncthreads();
#pragma unroll
        for (int i = 0; i < 4; ++i) { const int e = tid + 512 * i, s = e >> 4, seg = e & 15, cc = g * 128 + seg * 8;
            const u32x4 w = *(const u32x4*)(V + (tok0 + s) * DM + cc);
            const float sm_ = stat[(tok0 + s) * 2], sq_ = stat[(tok0 + s) * 2 + 1], mu = sm_ * (1.0f / DM), rs = rsqrtf(fmaxf(sq_ * (1.0f / DM) - mu * mu, 0.f) + 1e-5f);
            const f32x4 g0 = *(const f32x4*)(a.gmvg + cc), g1 = *(const f32x4*)(a.gmvg + cc + 4), b0 = *(const f32x4*)(a.gmvb + cc), b1 = *(const f32x4*)(a.gmvb + cc + 4);
            u32x4 o;
            o.x = pk2((bflo(w.x) - mu) * rs * g0[0] + b0[0], (bfhi(w.x) - mu) * rs * g0[1] + b0[1]); o.y = pk2((bflo(w.y) - mu) * rs * g0[2] + b0[2], (bfhi(w.y) - mu) * rs * g0[3] + b0[3]);
            o.z = pk2((bflo(w.z) - mu) * rs * g1[0] + b1[0], (bfhi(w.z) - mu) * rs * g1[1] + b1[1]); o.w = pk2((bflo(w.w) - mu) * rs * g1[2] + b1[2], (bfhi(w.w) - mu) * rs * g1[3] + b1[3]);
            *(LAS u32x4*)(vt + s * 136 + seg * 8) = o; }
        __syncthreads();
        f32x16 acc[2];
#pragma unroll
        for (int i = 0; i < 16; ++i) { acc[0][i] = 0.f; acc[1][i] = 0.f; }
#pragma unroll 2
        for (int ks = 0; ks < 2 * rb + 2; ++ks) {
            const int s0 = 16 * ks + 8 * h;
            const f32x4 w0 = *(const f32x4*)(wrow + s0), w1 = *(const f32x4*)(wrow + s0 + 4);
            bf16x8 af;
#pragma unroll
            for (int j = 0; j < 4; ++j) { af[j] = (short)f2bf(s0 + j <= t ? w0[j] : 0.f); af[4 + j] = (short)f2bf(s0 + 4 + j <= t ? w1[j] : 0.f); }
#pragma unroll
            for (int nb = 0; nb < 2; ++nb) { bf16x8 bfr;
#pragma unroll
                for (int j = 0; j < 8; ++j) bfr[j] = (short)vt[(s0 + j) * 136 + 64 * ch + 32 * nb + r];
                acc[nb] = __builtin_amdgcn_mfma_f32_32x32x16_bf16(af, bfr, acc[nb], 0, 0, 0); }
        }
#pragma unroll
        for (int nb = 0; nb < 2; ++nb)
#pragma unroll
            for (int i = 0; i < 16; ++i) { const int tt = 32 * rb + crow(i, h), dd = 64 * ch + 32 * nb + r;
                bf16_t* p = U + (tok0 + tt) * DM + g * 128 + dd; const bf16_t o_ = f2bf(bf2f(*p) * (acc[nb][i] + a.gmbs[g * 128 + tt])); if (!dry) *p = o_; }
    }
    for (int e = blockIdx.x * 512 + tid0; e < 128 * DM; e += gridDim.x * 512) {
        const int sq = e >> 10, c = e & 1023, g = c >> 7; const size_t row0 = (size_t)MP + sq * 4, base = row0 * DM + c;
        const float gg = a.gmvg[c], bb = a.gmvb[c];
        float v[4];
#pragma unroll
        for (int s = 0; s < 4; ++s) { const float sm_ = stat[(row0 + s) * 2], sq_ = stat[(row0 + s) * 2 + 1], mu = sm_ * (1.0f / DM), rs = rsqrtf(fmaxf(sq_ * (1.0f / DM) - mu * mu, 0.f) + 1e-5f);
            const float y = (bf2f(V[base + (size_t)s * DM]) - mu) * rs * gg + bb; if (!dry) a.out[O_GMV + ((size_t)sq * 4 + s) * DM + c] = y; v[s] = y; }
#pragma unroll
        for (int t = 0; t < 4; ++t) { float m = a.gmbs[g * 128 + t];
#pragma unroll
            for (int s = 0; s <= t; ++s) m += a.gmws[((size_t)g * 128 + t) * 128 + s] * v[s];
            bf16_t* p = U + base + (size_t)t * DM; const bf16_t o_ = f2bf(bf2f(*p) * m); if (!dry) *p = o_; }
    }
    __syncthreads();
}

DI void delta_seq_unit(const Args& a, LAS float* sm, int unit) {
    const int tid = threadIdx.x, j = tid & 127, qd = tid >> 7, lane = tid & 63, wid = tid >> 6;
    const bool prompt = unit < 64; const int uu = prompt ? unit : unit - 64, b = uu >> 3, h = uu & 7;
    const int T = prompt ? SEQ : 4; const size_t tok0 = prompt ? (size_t)b * SEQ : (size_t)MP + b * 4;
    const bf16_t* QKV = (const bf16_t*)(a.ws + W_Q); bf16_t* Z = (bf16_t*)(a.ws + W_Z);
    const float* betaA = (const float*)(a.ws + W_BETA); const float* glogA = (const float*)(a.ws + W_GLOG);
    float S[32];
    if (prompt) {
#pragma unroll
        for (int i = 0; i < 32; ++i) S[i] = 0.f;
    } else {
#pragma unroll
        for (int i = 0; i < 32; ++i) S[i] = a.st_ssm[(((size_t)b * 8 + h) * 128 + 32 * qd + i) * 128 + j];
    }
    const int part = tid >> 7, col = (part < 3 ? part : 0) * 1024 + h * 128 + j;
    float r0 = 0.f, r1 = 0.f, r2 = 0.f, cw0 = 0.f, cw1 = 0.f, cw2 = 0.f, cw3 = 0.f;
    if (tid < 384) { cw0 = a.convw[col]; cw1 = a.convw[3072 + col]; cw2 = a.convw[2 * 3072 + col]; cw3 = a.convw[3 * 3072 + col];
        if (!prompt) { r0 = a.st_conv[((size_t)b * 3 + 0) * 3072 + col]; r1 = a.st_conv[((size_t)b * 3 + 1) * 3072 + col]; r2 = a.st_conv[((size_t)b * 3 + 2) * 3072 + col]; } }
    const float dnw = a.dnw[j];
    const bf16_t* qp = QKV + tok0 * NQKV + col;
    float r3n = (tid < 384) ? bf2f(qp[0]) : 0.f;
    float betan = betaA[tok0 * 8 + h], gln = glogA[tok0 * 8 + h];
    float zn = (tid < 128) ? bf2f(Z[tok0 * DM + h * 128 + j]) : 0.f;
    for (int t = 0; t < T; ++t) {
        const size_t tok = tok0 + t;
        const float r3 = r3n, beta = betan, gl = gln, zc = zn;
        if (t + 1 < T) { if (tid < 384) r3n = bf2f(qp[(size_t)(t + 1) * NQKV]); betan = betaA[(tok + 1) * 8 + h]; gln = glogA[(tok + 1) * 8 + h]; if (tid < 128) zn = bf2f(Z[(tok + 1) * DM + h * 128 + j]); }
        if (tid < 384) {
            const float acc = r0 * cw0 + r1 * cw1 + r2 * cw2 + r3 * cw3; r0 = r1; r1 = r2; r2 = r3;
            const float val = siluf_(acc); sm[tid] = val;
            const float ss = wave_sum(val * val); if (lane == 0) sm[384 + wid] = ss;
        }
        __syncthreads();
        const float nq = rsqrtf(sm[384] + sm[385] + 1e-6f) * 0.08838834764831845f, nk = rsqrtf(sm[386] + sm[387] + 1e-6f);
        const float g = __expf(gl);
        float d = 0.f;
#pragma unroll
        for (int i = 0; i < 32; ++i) d += S[i] * sm[128 + 32 * qd + i];
        sm[400 + qd * 128 + j] = d * nk;
        __syncthreads();
        const float dt = sm[400 + j] + sm[528 + j] + sm[656 + j] + sm[784 + j];
        const float vn = beta * (sm[256 + j] - g * dt);
        float o = 0.f;
#pragma unroll
        for (int i = 0; i < 32; ++i) { const float kk = sm[128 + 32 * qd + i] * nk; S[i] = g * S[i] + kk * vn; o += S[i] * sm[32 * qd + i]; }
        sm[1024 + qd * 128 + j] = o * nq;
        __syncthreads();
        float ot = 0.f;
        if (tid < 128) { ot = sm[1024 + j] + sm[1152 + j] + sm[1280 + j] + sm[1408 + j]; const float ss = wave_sum(ot * ot); if (lane == 0) sm[392 + wid] = ss; }
        __syncthreads();
        if (tid < 128) { const float ms = (sm[392] + sm[393]) * (1.0f / 128.0f);
            Z[tok * DM + h * 128 + j] = f2bf(ot * rsqrtf(ms + 1e-6f) * dnw * zc); }
    }
    float* so = a.out + (prompt ? O_SSMP : O_SSMS) + ((size_t)b * 8 + h) * 128 * 128;
#pragma unroll
    for (int i = 0; i < 32; ++i) so[(size_t)(32 * qd + i) * 128 + j] = S[i];
    __syncthreads();
}
DI void phase_delta_seq(const Args& a, LAS unsigned char* lds) {
    for (int unit = blockIdx.x; unit < 64 + 1024; unit += gridDim.x) delta_seq_unit(a, (LAS float*)lds, unit);
}


typedef short s16x4 __attribute__((ext_vector_type(4)));
DI bf16x8 pack8(float a0, float a1, float a2, float a3, float a4, float a5, float a6, float a7) {
    const u32x4 p = {cvt2(a0, a1), cvt2(a2, a3), cvt2(a4, a5), cvt2(a6, a7)}; return __builtin_bit_cast(bf16x8, p); }
template <int S_> DI bf16x8 pack_step(const f32x16& x) { return pack8(x[8 * S_], x[8 * S_ + 1], x[8 * S_ + 2], x[8 * S_ + 3], x[8 * S_ + 4], x[8 * S_ + 5], x[8 * S_ + 6], x[8 * S_ + 7]); }
#define MFMA32(a, b, c) __builtin_amdgcn_mfma_f32_32x32x16_bf16((a), (b), (c), 0, 0, 0)
constexpr size_t W_QKM = W_UP1, W_SIDE = W_UP1 + (size_t)2048 * 3072 * 2, W_TM = W_IN;
static_assert(W_SIDE + (size_t)256 * 3 * NQKV * 2 <= W_IN, "side buffer must fit behind QKm");

template <int PART> DI void conv_vals(const LAS bf16_t* rawt, const LAS float* cwl, int r, int ch, float (&acc)[8]) {
#pragma unroll
    for (int j = 0; j < 8; ++j) acc[j] = 0.f;
#pragma unroll
    for (int i = 0; i < 4; ++i) {
        const u32x4 raw = *(const LAS u32x4*)(rawt + (r + i) * 136 + ch);
        const f32x4 w0 = *(const LAS f32x4*)(cwl + ((PART * 4 + i) * 128 + ch)), w1 = *(const LAS f32x4*)(cwl + ((PART * 4 + i) * 128 + ch + 4));
        acc[0] += bflo(raw.x) * w0[0]; acc[1] += bfhi(raw.x) * w0[1]; acc[2] += bflo(raw.y) * w0[2]; acc[3] += bfhi(raw.y) * w0[3];
        acc[4] += bflo(raw.z) * w1[0]; acc[5] += bfhi(raw.z) * w1[1]; acc[6] += bflo(raw.w) * w1[2]; acc[7] += bfhi(raw.w) * w1[3];
    }
#pragma unroll
    for (int j = 0; j < 8; ++j) acc[j] = siluf_(acc[j]);
}
template <int PART> DI void conv_block(bf16_t* qb, const bf16_t* sb, LAS bf16_t* rawt, const LAS float* cwl, bool first, int h, int mb, int lane, bf16x8 (&frag)[8], bool dry) {
    const int r = lane & 31, hh = lane >> 5, tl = 32 * mb + r, colb = PART * 1024 + h * 128;
#pragma unroll
    for (int it = 0; it < 9; ++it) { const int p = lane + 64 * it, rr = p >> 4, seg = p & 15, tr = 32 * mb - 3 + rr;
        if (p < 560) { u32x4 v = {0u, 0u, 0u, 0u};
            if (tr >= 0) v = *(const u32x4*)(qb + (tr * NQKV + colb + seg * 8));
            else if (!first) v = *(const u32x4*)(sb + ((tr + 3) * NQKV + colb + seg * 8));
            *(LAS u32x4*)(rawt + rr * 136 + seg * 8) = v; } }
    float sc = 1.0f;
    if (PART < 2) {
        float ss = 0.f;
#pragma unroll 2
        for (int ks = 0; ks < 8; ++ks) { float acc[8]; conv_vals<PART>(rawt, cwl, r, 8 * hh + 16 * ks, acc);
#pragma unroll
            for (int j = 0; j < 8; ++j) ss += acc[j] * acc[j]; }
        ss += __shfl_xor(ss, 32, 64); sc = rsqrtf(ss + 1e-6f) * (PART == 0 ? 0.08838834764831845f : 1.0f);
    }
#pragma unroll
    for (int ks = 0; ks < 8; ++ks) {
        float acc[8]; conv_vals<PART>(rawt, cwl, r, 8 * hh + 16 * ks, acc);
        frag[ks] = pack8(acc[0] * sc, acc[1] * sc, acc[2] * sc, acc[3] * sc, acc[4] * sc, acc[5] * sc, acc[6] * sc, acc[7] * sc);
        if (!dry) *(bf16x8*)(qb + (tl * NQKV + colb + 8 * hh + 16 * ks)) = frag[ks];
        if ((ks & 1) == 1) asm volatile("" ::: "memory");
    }
}
DI void phase_delta_pre(const Args& a, LAS unsigned char* lds, bool dry) {
    bf16_t* QKV = (bf16_t*)(a.ws + W_Q); const bf16_t* side = (const bf16_t*)(a.ws + W_SIDE);
    float* glogA = (float*)(a.ws + W_GLOG); const float* betaA = (const float*)(a.ws + W_BETA);
    bf16_t* Tg = (bf16_t*)(a.ws + W_TM); bf16_t* Qg = (bf16_t*)(a.ws + W_QKM);
    const int tid = threadIdx.x, wid = tid >> 6;
    LAS float* Aw0 = (LAS float*)lds + wid * 4096; LAS float* vG0 = (LAS float*)(lds + 131072) + wid * 128; LAS float* cwl = (LAS float*)(lds + 135168);
#pragma unroll 1
    for (int inst = blockIdx.x * 8 + wid; inst < 2048; inst += gridDim.x * 8) {
        int lane = tid & 63; asm volatile("" : "+v"(lane));
        const int r = lane & 31, hh = lane >> 5;
        LAS float* Aw = Aw0; LAS float* vG = vG0; LAS float* vB = vG + 64;
        const int b = inst >> 8, h = (inst >> 5) & 7, c = inst & 31; const size_t tok0 = (size_t)b * SEQ + c * 64;
        __syncthreads();
        for (int e = tid; e < 1536; e += 512) cwl[e] = a.convw[(e >> 7) % 4 * NQKV + (e >> 9) * 1024 + h * 128 + (e & 127)];
        __syncthreads();
        float G = glogA[(tok0 + lane) * 8 + h];
#pragma unroll
        for (int o = 1; o < 64; o <<= 1) { const float t = __shfl_up(G, o, 64); if (lane >= o) G += t; }
        if (!dry) glogA[(tok0 + lane) * 8 + h] = G;
        vG[lane] = G; vB[lane] = betaA[(tok0 + lane) * 8 + h];
        const bool first = (c == 0); bf16_t* qb = QKV + tok0 * NQKV; const bf16_t* sb = side + ((size_t)b * 32 + c) * 3 * NQKV;
        bf16x8 fq[2][8], fk[2][8];
        { bf16x8 fv[8]; conv_block<2>(qb, sb, (LAS bf16_t*)Aw, cwl, first, h, 1, lane, fv, dry); conv_block<2>(qb, sb, (LAS bf16_t*)Aw, cwl, first, h, 0, lane, fv, dry); }
        conv_block<1>(qb, sb, (LAS bf16_t*)Aw, cwl, first, h, 1, lane, fk[1], dry); conv_block<1>(qb, sb, (LAS bf16_t*)Aw, cwl, first, h, 0, lane, fk[0], dry);
        conv_block<0>(qb, sb, (LAS bf16_t*)Aw, cwl, first, h, 1, lane, fq[1], dry); conv_block<0>(qb, sb, (LAS bf16_t*)Aw, cwl, first, h, 0, lane, fq[0], dry);
        f32x16 g00, g10, g11;
#pragma unroll
        for (int i = 0; i < 16; ++i) { g00[i] = 0.f; g10[i] = 0.f; g11[i] = 0.f; }
#pragma unroll
        for (int ks = 0; ks < 8; ++ks) { g00 = MFMA32(fk[0][ks], fk[0][ks], g00); g10 = MFMA32(fk[1][ks], fk[0][ks], g10); g11 = MFMA32(fk[1][ks], fk[1][ks], g11); }
#pragma unroll
        for (int ii = 0; ii < 16; ++ii) {
            const int i0 = crow(ii, hh), i1 = 32 + i0;
            const float G0 = vG[i0], G1 = vG[i1], B0 = vB[i0], B1 = vB[i1], Gr0 = vG[r], Gr1 = vG[32 + r];
            Aw[i0 * 64 + r] = (r < i0) ? B0 * g00[ii] * __expf(G0 - Gr0) : 0.f;
            Aw[i1 * 64 + r] = B1 * g10[ii] * __expf(G1 - Gr0);
            Aw[i1 * 64 + 32 + r] = (r < i0) ? B1 * g11[ii] * __expf(G1 - Gr1) : 0.f;
        }
#pragma unroll
        for (int i = 0; i < 16; ++i) { g00[i] = 0.f; g10[i] = 0.f; g11[i] = 0.f; }
#pragma unroll
        for (int ks = 0; ks < 8; ++ks) { g00 = MFMA32(fq[0][ks], fk[0][ks], g00); g10 = MFMA32(fq[1][ks], fk[0][ks], g10); g11 = MFMA32(fq[1][ks], fk[1][ks], g11); }
        bf16_t* qo = Qg + (size_t)inst * 3072;
#pragma unroll
        for (int ii = 0; ii < 16; ++ii) {
            const int i0 = crow(ii, hh), i1 = 32 + i0;
            const float G0 = vG[i0], G1 = vG[i1], Gr0 = vG[r], Gr1 = vG[32 + r];
            if (!dry) qo[i0 * 32 + r] = f2bf((r <= i0) ? g00[ii] * __expf(G0 - Gr0) : 0.f);
            if (!dry) qo[1024 + i0 * 32 + r] = f2bf(g10[ii] * __expf(G1 - Gr0));
            if (!dry) qo[2048 + i0 * 32 + r] = f2bf((r <= i0) ? g11[ii] * __expf(G1 - Gr1) : 0.f);
        }
#pragma unroll 1
        for (int i = 0; i < 64; i += 2) {
            const LAS float* ar = Aw + i * 64; const LAS float* br = ar + 64;
            float a0 = (lane == i) ? 1.f : 0.f, a1 = 0.f, b0 = (lane == i + 1) ? 1.f : 0.f, b1 = 0.f; int j = 0;
#pragma unroll 2
            for (; j + 4 <= i; j += 4) { const f32x4 a4 = *(const LAS f32x4*)(ar + j), b4 = *(const LAS f32x4*)(br + j);
                const float t0 = Aw[j * 64 + lane], t1 = Aw[(j + 1) * 64 + lane], t2 = Aw[(j + 2) * 64 + lane], t3 = Aw[(j + 3) * 64 + lane];
                a0 -= a4[0] * t0; b0 -= b4[0] * t0; a1 -= a4[1] * t1; b1 -= b4[1] * t1; a0 -= a4[2] * t2; b0 -= b4[2] * t2; a1 -= a4[3] * t3; b1 -= b4[3] * t3; }
            if (j < i) { const float t0 = Aw[j * 64 + lane], t1 = Aw[(j + 1) * 64 + lane];
                a0 -= ar[j] * t0; b0 -= br[j] * t0; a1 -= ar[j + 1] * t1; b1 -= br[j + 1] * t1; }
            const float xi = a0 + a1, ci = br[i], xj = (b0 + b1) - ci * xi;
            Aw[i * 64 + lane] = xi; Aw[(i + 1) * 64 + lane] = xj;
        }
        bf16_t* to = Tg + (size_t)inst * 3072;
#pragma unroll 4
        for (int i = 0; i < 32; ++i) {
            if (lane < 32 && !dry) to[i * 32 + lane] = f2bf(Aw[i * 64 + lane]);
            if (!dry) to[(lane < 32 ? 1024 : 2048) + i * 32 + (lane & 31)] = f2bf(Aw[(32 + i) * 64 + lane]);
        }
    }
}

DI bf16x8 lds_frag(const LAS bf16_t* p) { const u32x2 lo = *(const LAS u32x2*)p, hi = *(const LAS u32x2*)(p + 8); const u32x4 v = {lo.x, lo.y, hi.x, hi.y}; return __builtin_bit_cast(bf16x8, v); }
DI bf16x8 lds_frag_tr(const LAS bf16_t* lo_p) {
    const s16x4 lo = __builtin_amdgcn_ds_read_tr16_b64_v4i16((LAS s16x4*)lo_p), hi = __builtin_amdgcn_ds_read_tr16_b64_v4i16((LAS s16x4*)(lo_p + 8 * 136));
    return __builtin_shufflevector(lo, hi, 0, 1, 2, 3, 4, 5, 6, 7); }
DI void delta_scan_unit(const Args& a, LAS unsigned char* lds, int unit) {
    const int tid0 = threadIdx.x, wid = tid0 >> 6, b = unit >> 3, h = unit & 7, dv0 = 32 * (wid & 3);
    LAS bf16_t* KN = (LAS bf16_t*)lds; LAS bf16_t* QN = (LAS bf16_t*)(lds + 17408); LAS bf16_t* VC = (LAS bf16_t*)(lds + 34816);
    LAS bf16_t* TI = (LAS bf16_t*)(lds + 52224); LAS bf16_t* QI = (LAS bf16_t*)(lds + 61440); LAS float* OT0 = (LAS float*)(lds + 70656); LAS float* VE = (LAS float*)(lds + 138240);
    const bf16_t* QKV = (const bf16_t*)(a.ws + W_Q); const bf16_t* Tg = (const bf16_t*)(a.ws + W_TM); const bf16_t* Qg = (const bf16_t*)(a.ws + W_QKM);
    const float* Gc = (const float*)(a.ws + W_GLOG); const float* betaA = (const float*)(a.ws + W_BETA); bf16_t* Z = (bf16_t*)(a.ws + W_Z);
    f32x16 S[4];
#pragma unroll
    for (int d = 0; d < 4; ++d)
#pragma unroll
        for (int i = 0; i < 16; ++i) S[d][i] = 0.f;
#define NORMALIZE(cc, OTn, lt, zz) do { const size_t tokn = (size_t)b * SEQ + (cc) * 64; const int nrow = (lt) >> 2, nseg = (lt) & 3; \
        bf16_t* zp = Z + (tokn + nrow) * DM + h * 128 + nseg * 32; const LAS float* op = (OTn) + nrow * 132 + nseg * 32; \
        f32x4 ov[8]; float ss = 0.f; \
        _Pragma("unroll") for (int i = 0; i < 8; ++i) { ov[i] = *(const LAS f32x4*)(op + 4 * i); ss += ov[i][0] * ov[i][0] + ov[i][1] * ov[i][1] + ov[i][2] * ov[i][2] + ov[i][3] * ov[i][3]; } \
        ss += __shfl_xor(ss, 1, 64); ss += __shfl_xor(ss, 2, 64); \
        const float sc = rsqrtf(ss * (1.0f / 128.0f) + 1e-6f); \
        _Pragma("unroll") for (int i = 0; i < 4; ++i) { const f32x4 d0 = *(const f32x4*)(a.dnw + nseg * 32 + 8 * i), d1 = *(const f32x4*)(a.dnw + nseg * 32 + 8 * i + 4); const f32x4 o0 = ov[2 * i], o1 = ov[2 * i + 1]; u32x4 w; \
            w.x = cvt2(o0[0] * sc * d0[0] * bflo(zz[i].x), o0[1] * sc * d0[1] * bfhi(zz[i].x)); w.y = cvt2(o0[2] * sc * d0[2] * bflo(zz[i].y), o0[3] * sc * d0[3] * bfhi(zz[i].y)); \
            w.z = cvt2(o1[0] * sc * d1[0] * bflo(zz[i].z), o1[1] * sc * d1[1] * bfhi(zz[i].z)); w.w = cvt2(o1[2] * sc * d1[2] * bflo(zz[i].w), o1[3] * sc * d1[3] * bfhi(zz[i].w)); \
            *(u32x4*)(zp + 8 * i) = w; } } while (0)
    const bool computer = __builtin_amdgcn_readfirstlane(wid) < 4;
#pragma unroll 1
    for (int c = -1; c < 32; ++c) {
        int tid = tid0; asm volatile("" : "+v"(tid));
        const int lane = tid & 63, r = lane & 31, hh = lane >> 5;
        LAS float* OTc = OT0 + (c & 1) * 8448;
        __syncthreads();
        if (computer) {
            if (c >= 0) {
            f32x16 ks[2];
#pragma unroll
            for (int m = 0; m < 2; ++m)
#pragma unroll
                for (int i = 0; i < 16; ++i) ks[m][i] = 0.f;
#pragma unroll
            for (int d = 0; d < 4; ++d) { const bf16x8 sb0 = pack_step<0>(S[d]), sb1 = pack_step<1>(S[d]);
#pragma unroll
                for (int m = 0; m < 2; ++m) { const int off = (32 * m + r) * 136 + 32 * d + 4 * hh;
                    ks[m] = MFMA32(lds_frag(KN + off), sb0, ks[m]); ks[m] = MFMA32(lds_frag(KN + off + 16), sb1, ks[m]); } }
            f32x16 rhs[2];
#pragma unroll
            for (int m = 0; m < 2; ++m)
#pragma unroll
                for (int g4 = 0; g4 < 4; ++g4) { const int rb0 = 32 * m + 8 * g4 + 4 * hh;
                    const f32x4 bt4 = *(const LAS f32x4*)(VE + 64 + rb0), eg4 = *(const LAS f32x4*)(VE + rb0);
                    const s16x4 v4 = __builtin_amdgcn_ds_read_tr16_b64_v4i16((LAS s16x4*)(VC + (rb0 + ((lane & 15) >> 2)) * 136 + dv0 + 16 * ((lane >> 4) & 1) + 4 * (lane & 3)));
#pragma unroll
                    for (int jj = 0; jj < 4; ++jj) rhs[m][4 * g4 + jj] = bt4[jj] * (bf2f((bf16_t)v4[jj]) - eg4[jj] * ks[m][4 * g4 + jj]); }
            bf16x8 Rb[2][2]; Rb[0][0] = pack_step<0>(rhs[0]); Rb[0][1] = pack_step<1>(rhs[0]); Rb[1][0] = pack_step<0>(rhs[1]); Rb[1][1] = pack_step<1>(rhs[1]);
            f32x16 vn[2];
#pragma unroll
            for (int i = 0; i < 16; ++i) { vn[0][i] = 0.f; vn[1][i] = 0.f; }
#pragma unroll
            for (int s = 0; s < 2; ++s) vn[0] = MFMA32(lds_frag(TI + r * 72 + 16 * s + 4 * hh), Rb[0][s], vn[0]);
#pragma unroll
            for (int m = 0; m < 2; ++m)
#pragma unroll
                for (int s = 0; s < 2; ++s) vn[1] = MFMA32(lds_frag(TI + (32 + r) * 72 + 32 * m + 16 * s + 4 * hh), Rb[m][s], vn[1]);
            bf16x8 Vb[2][2]; Vb[0][0] = pack_step<0>(vn[0]); Vb[0][1] = pack_step<1>(vn[0]); Vb[1][0] = pack_step<0>(vn[1]); Vb[1][1] = pack_step<1>(vn[1]);
            f32x16 qs[2];
#pragma unroll
            for (int m = 0; m < 2; ++m)
#pragma unroll
                for (int i = 0; i < 16; ++i) qs[m][i] = 0.f;
#pragma unroll
            for (int d = 0; d < 4; ++d) { const bf16x8 sb0 = pack_step<0>(S[d]), sb1 = pack_step<1>(S[d]);
#pragma unroll
                for (int m = 0; m < 2; ++m) { const int off = (32 * m + r) * 136 + 32 * d + 4 * hh;
                    qs[m] = MFMA32(lds_frag(QN + off), sb0, qs[m]); qs[m] = MFMA32(lds_frag(QN + off + 16), sb1, qs[m]); } }
            f32x16 o[2];
#pragma unroll
            for (int i = 0; i < 16; ++i) { o[0][i] = 0.f; o[1][i] = 0.f; }
#pragma unroll
            for (int s = 0; s < 2; ++s) o[0] = MFMA32(lds_frag(QI + r * 72 + 16 * s + 4 * hh), Vb[0][s], o[0]);
#pragma unroll
            for (int m = 0; m < 2; ++m)
#pragma unroll
                for (int s = 0; s < 2; ++s) o[1] = MFMA32(lds_frag(QI + (32 + r) * 72 + 32 * m + 16 * s + 4 * hh), Vb[m][s], o[1]);
#pragma unroll
            for (int m = 0; m < 2; ++m)
#pragma unroll
                for (int g4 = 0; g4 < 4; ++g4) { const int rb0 = 32 * m + 8 * g4 + 4 * hh; const f32x4 eg4 = *(const LAS f32x4*)(VE + rb0);
#pragma unroll
                    for (int jj = 0; jj < 4; ++jj) OTc[(rb0 + jj) * 132 + dv0 + r] = o[m][4 * g4 + jj] + eg4[jj] * qs[m][4 * g4 + jj]; }
            f32x16 wv[2];
#pragma unroll
            for (int m = 0; m < 2; ++m)
#pragma unroll
                for (int g4 = 0; g4 < 4; ++g4) { const f32x4 ed4 = *(const LAS f32x4*)(VE + 128 + 32 * m + 8 * g4 + 4 * hh);
#pragma unroll
                    for (int jj = 0; jj < 4; ++jj) wv[m][4 * g4 + jj] = vn[m][4 * g4 + jj] * ed4[jj]; }
            bf16x8 Wb[2][2]; Wb[0][0] = pack_step<0>(wv[0]); Wb[0][1] = pack_step<1>(wv[0]); Wb[1][0] = pack_step<0>(wv[1]); Wb[1][1] = pack_step<1>(wv[1]);
            const float eL = VE[63];
            const int i16 = lane & 15, blk = (lane >> 4) & 1, tq = i16 >> 2, tp = i16 & 3;
#pragma unroll
            for (int d = 0; d < 4; ++d) {
#pragma unroll
                for (int i = 0; i < 16; ++i) S[d][i] *= eL;
#pragma unroll
                for (int m = 0; m < 2; ++m)
#pragma unroll
                    for (int s = 0; s < 2; ++s)
                        S[d] = MFMA32(lds_frag_tr(KN + (32 * m + 16 * s + 4 * hh + tq) * 136 + 32 * d + 16 * blk + 4 * tp), Wb[m][s], S[d]);
            }
            }
            __syncthreads();
        } else {
            u32x4 pf[15], zz[4]; float pG = 0.f, pGL = 0.f, pB = 0.f;
            const int ltv = tid - 256, cn = c + 1 < 32 ? c + 1 : 31;
            { const int cp = c > 0 ? c - 1 : 0; const bf16_t* zq = Z + ((size_t)b * SEQ + cp * 64 + (ltv >> 2)) * DM + h * 128 + (ltv & 3) * 32;
#pragma unroll
              for (int i = 0; i < 4; ++i) zz[i] = *(const u32x4*)(zq + 8 * i); }
            const size_t tok1 = (size_t)b * SEQ + cn * 64; const size_t inst = ((size_t)b * 8 + h) * 32 + cn;
            const bf16_t* qb = QKV + tok1 * NQKV + h * 128; const bf16_t* tb = Tg + inst * 3072; const bf16_t* qg = Qg + inst * 3072;
#pragma unroll
            for (int i = 0; i < 12; ++i) { const int p = ltv + 256 * i, part = p >> 10, row = (p & 1023) >> 4, seg = p & 15; pf[i] = *(const u32x4*)(qb + (row * NQKV + part * 1024 + seg * 8)); }
#pragma unroll
            for (int i = 0; i < 3; ++i) { const int p = ltv + 256 * i, m = p >= 384, q = m ? p - 384 : p; pf[12 + i] = *(const u32x4*)((m ? qg : tb) + q * 8); }
            if (ltv < 64) { pG = Gc[(tok1 + ltv) * 8 + h]; pGL = Gc[(tok1 + 63) * 8 + h]; pB = betaA[(tok1 + ltv) * 8 + h]; }
            if (c > 0) NORMALIZE(c - 1, OT0 + ((c - 1) & 1) * 8448, ltv, zz);
            __syncthreads();
            if (c + 1 < 32) {
#pragma unroll
                for (int i = 0; i < 12; ++i) { const int p = ltv + 256 * i, part = p >> 10, row = (p & 1023) >> 4, seg = p & 15;
                    *(LAS u32x4*)((part == 0 ? QN : (part == 1 ? KN : VC)) + row * 136 + seg * 8) = pf[i]; }
#pragma unroll
                for (int i = 0; i < 3; ++i) { const int p = ltv + 256 * i, m = p >= 384, q = m ? p - 384 : p, blk = q >> 7, rr = (q & 127) >> 2, c8 = (q & 3) * 8;
                    *(LAS u32x4*)((m ? QI : TI) + (32 * (blk > 0) + rr) * 72 + 32 * (blk == 2) + c8) = pf[12 + i]; }
                if (ltv < 64) { VE[ltv] = __expf(pG); VE[64 + ltv] = pB; VE[128 + ltv] = __expf(pGL - pG); }
            }
        }
    }
    __syncthreads();
    int tidf = tid0; asm volatile("" : "+v"(tidf));
    if (!computer) { u32x4 zz[4]; const int ltf = tidf - 256; const bf16_t* zq = Z + ((size_t)b * SEQ + 31 * 64 + (ltf >> 2)) * DM + h * 128 + (ltf & 3) * 32;
#pragma unroll
        for (int i = 0; i < 4; ++i) zz[i] = *(const u32x4*)(zq + 8 * i);
        NORMALIZE(31, OT0 + 8448, ltf, zz); }
#undef NORMALIZE
    const int lane = tidf & 63, r = lane & 31, hh = lane >> 5;
    if (wid < 4) { float* so = a.out + O_SSMP + ((size_t)b * 8 + h) * 128 * 128;
#pragma unroll
        for (int d = 0; d < 4; ++d)
#pragma unroll
            for (int ii = 0; ii < 16; ++ii) so[(size_t)(32 * d + crow(ii, hh)) * 128 + dv0 + r] = S[d][ii]; }
    __syncthreads();
}

DI void delta_sample2(const Args& a, LAS float* sm, int pair) {
    const int tid = threadIdx.x, j = tid & 127, qd = tid >> 7, lane = tid & 63, wid = tid >> 6, b = pair >> 2, h0 = (pair & 3) * 2;
    const size_t tok0 = (size_t)MP + b * 4;
    const bf16_t* QKV = (const bf16_t*)(a.ws + W_Q); bf16_t* Z = (bf16_t*)(a.ws + W_Z);
    const float* betaA = (const float*)(a.ws + W_BETA); const float* glogA = (const float*)(a.ws + W_GLOG);
    float S[2][32], r0[2], r1[2], r2[2], cw[2][4], r3n[2], betan[2], gln[2], zn[2];
    const int part = tid >> 7, pc = (part < 3 ? part : 0) * 1024 + j;
#pragma unroll
    for (int u = 0; u < 2; ++u) { const int h = h0 + u, col = pc + h * 128;
        const float* sp = a.st_ssm + (((size_t)b * 8 + h) * 128 + 32 * qd) * 128;
#pragma unroll
        for (int i = 0; i < 32; ++i) S[u][i] = sp[i * 128 + j];
        r0[u] = r1[u] = r2[u] = 0.f; r3n[u] = 0.f; zn[u] = 0.f;
#pragma unroll
        for (int i = 0; i < 4; ++i) cw[u][i] = 0.f;
        if (tid < 384) {
#pragma unroll
            for (int i = 0; i < 4; ++i) cw[u][i] = a.convw[i * NQKV + col];
            r0[u] = a.st_conv[((size_t)b * 3 + 0) * NQKV + col]; r1[u] = a.st_conv[((size_t)b * 3 + 1) * NQKV + col]; r2[u] = a.st_conv[((size_t)b * 3 + 2) * NQKV + col];
            r3n[u] = bf2f(QKV[tok0 * NQKV + col]); }
        betan[u] = betaA[tok0 * 8 + h]; gln[u] = glogA[tok0 * 8 + h];
        if (tid < 128) zn[u] = bf2f(Z[tok0 * DM + h * 128 + j]); }
    const float dnw = a.dnw[j];
#pragma unroll 1
    for (int t = 0; t < 4; ++t) {
        const size_t tok = tok0 + t; float r3[2], beta[2], gl[2], zc[2];
#pragma unroll
        for (int u = 0; u < 2; ++u) { const int h = h0 + u; r3[u] = r3n[u]; beta[u] = betan[u]; gl[u] = gln[u]; zc[u] = zn[u];
            if (t < 3) { if (tid < 384) r3n[u] = bf2f(QKV[(tok + 1) * NQKV + pc + h * 128]); betan[u] = betaA[(tok + 1) * 8 + h]; gln[u] = glogA[(tok + 1) * 8 + h]; if (tid < 128) zn[u] = bf2f(Z[(tok + 1) * DM + h * 128 + j]); } }
        if (tid < 384) {
#pragma unroll
            for (int u = 0; u < 2; ++u) { const float acc = r0[u] * cw[u][0] + r1[u] * cw[u][1] + r2[u] * cw[u][2] + r3[u] * cw[u][3]; r0[u] = r1[u]; r1[u] = r2[u]; r2[u] = r3[u];
                const float val = siluf_(acc); sm[u * 1536 + tid] = val; const float ss = wave_sum(val * val); if (lane == 0) sm[u * 1536 + 384 + wid] = ss; }
        }
        __syncthreads();
        float nq[2], nk[2], g[2];
#pragma unroll
        for (int u = 0; u < 2; ++u) { LAS float* su = sm + u * 1536;
            nq[u] = rsqrtf(su[384] + su[385] + 1e-6f) * 0.08838834764831845f; nk[u] = rsqrtf(su[386] + su[387] + 1e-6f); g[u] = __expf(gl[u]);
            float d = 0.f;
#pragma unroll
            for (int i = 0; i < 32; ++i) d += S[u][i] * su[128 + 32 * qd + i];
            su[400 + qd * 128 + j] = d * nk[u]; }
        __syncthreads();
#pragma unroll
        for (int u = 0; u < 2; ++u) { LAS float* su = sm + u * 1536;
            const float dt = su[400 + j] + su[528 + j] + su[656 + j] + su[784 + j];
            const float vn = beta[u] * (su[256 + j] - g[u] * dt) * nk[u];
            float o = 0.f;
#pragma unroll
            for (int i = 0; i < 32; ++i) { S[u][i] = g[u] * S[u][i] + su[128 + 32 * qd + i] * vn; o += S[u][i] * su[32 * qd + i]; }
            su[1024 + qd * 128 + j] = o * nq[u]; }
        __syncthreads();
        float ot[2] = {0.f, 0.f};
        if (tid < 128) {
#pragma unroll
            for (int u = 0; u < 2; ++u) { LAS float* su = sm + u * 1536; ot[u] = su[1024 + j] + su[1152 + j] + su[1280 + j] + su[1408 + j]; const float ss = wave_sum(ot[u] * ot[u]); if (lane == 0) su[392 + wid] = ss; } }
        __syncthreads();
        if (tid < 128) {
#pragma unroll
            for (int u = 0; u < 2; ++u) { LAS float* su = sm + u * 1536; const float ms = (su[392] + su[393]) * (1.0f / 128.0f);
                Z[tok * DM + (h0 + u) * 128 + j] = f2bf(ot[u] * rsqrtf(ms + 1e-6f) * dnw * zc[u]); } }
    }
#pragma unroll
    for (int u = 0; u < 2; ++u) { float* so = a.out + O_SSMS + (((size_t)b * 8 + h0 + u) * 128 + 32 * qd) * 128;
#pragma unroll
        for (int i = 0; i < 32; ++i) so[i * 128 + j] = S[u][i]; }
    __syncthreads();
}
DI void phase_delta_scan(const Args& a, LAS unsigned char* lds) {
    const int G = (int)gridDim.x, bi = (int)blockIdx.x, nscan = G > 64 ? 64 : 0;
    if (bi < nscan) { delta_scan_unit(a, lds, bi); return; }
    if (nscan == 0) {
#pragma unroll 1
        for (int u = bi; u < 64; u += G) delta_scan_unit(a, lds, u);
    }
#pragma unroll 1
    for (int pair = bi - nscan; pair < 512; pair += G - nscan) delta_sample2(a, (LAS float*)lds, pair);
    { pg8::Gemm g{(const bf16_t*)(a.ws + W_U), (const bf16_t*)(a.ws + W_BA), MT, DM, DM, DM}; pg8::StaticOrder S; S.init(MT, DM, G - nscan, bi - nscan);
      pg8::gemm_phase<EpiM1, pg8::StaticOrder>(lds, g, S, EpiM1{(bf16_t*)(a.out + O_Y)}); }
}

#define XB_TMO      128
#define XB_XCNT(j)  (256  + 64 * (j))
#define XB_XSUB(j)  (1280 + 64 * (j))
#define XB_XGEN(j)  (2304 + 64 * (j))
#define XB_TOP      3328
#define XB_TOPGEN   3392
#define XCD_BAR_WORDS 3456
#define XB_SPIN_CAP (1u << 18)

__device__ __forceinline__ unsigned xb_ld(unsigned* p)              { return __hip_atomic_load(p, __ATOMIC_RELAXED, __HIP_MEMORY_SCOPE_AGENT); }
__device__ __forceinline__ unsigned xb_add(unsigned* p, unsigned v) { return __hip_atomic_fetch_add(p, v, __ATOMIC_RELAXED, __HIP_MEMORY_SCOPE_AGENT); }
__device__ __forceinline__ unsigned xb_xcc_id() { return (unsigned)__builtin_amdgcn_s_getreg((3 << 11) | 20) & 0xFu; }
#define XB_SPIN(cond, bar) do { unsigned _sp = 0; while (cond) { __builtin_amdgcn_s_sleep(1); \
    if ((++_sp & 255u) == 0u) { if (xb_ld(&(bar)[XB_TMO])) break; if (_sp > XB_SPIN_CAP) { atomicAdd(&(bar)[XB_TMO], 1u); break; } } } } while (0)

struct XcdBarrier {
    unsigned* bar; unsigned x;
    volatile LAS unsigned* st;
};

__device__ __forceinline__ XcdBarrier xcd_barrier_post(unsigned* bar, volatile LAS unsigned* st) {
    XcdBarrier b; b.bar = bar; b.x = xb_xcc_id(); b.st = st;
    if (threadIdx.x == 0) (void)xb_add(&bar[XB_XCNT(b.x)], 1u);
    return b;
}
__device__ __forceinline__ void xcd_barrier_complete(unsigned* bar, unsigned x, unsigned& nloc, unsigned& nx) {
    const unsigned G = gridDim.x * gridDim.y * gridDim.z;
    unsigned sum, cnt, mine, sp = 0u;
    for (;;) {
        sum = 0u; cnt = 0u; mine = 0u;
#pragma unroll
        for (unsigned j = 0; j < 16; ++j) { const unsigned c = xb_ld(&bar[XB_XCNT(j)]); sum += c; cnt += (c > 0u) ? 1u : 0u; mine = (j == x) ? c : mine; }
        if (sum == G) break;
        __builtin_amdgcn_s_sleep(1);
        if ((++sp & 255u) == 0u) { if (xb_ld(&bar[XB_TMO])) break; if (sp > XB_SPIN_CAP) { atomicAdd(&bar[XB_TMO], 1u); break; } }
    }
    nloc = mine > 0u ? mine : 1u; nx = cnt > 0u ? cnt : 1u;
}

__device__ __forceinline__ void xcd_barrier(const XcdBarrier& b) {
    asm volatile("s_waitcnt vmcnt(0)" ::: "memory");
    __syncthreads();
    if (threadIdx.x == 0) {
        unsigned* bar = b.bar;
        __builtin_amdgcn_s_waitcnt(0);
        unsigned nloc = b.st[0], nx = b.st[1];
        if (nloc == 0u) { xcd_barrier_complete(bar, b.x, nloc, nx); b.st[0] = nloc; b.st[1] = nx; }
        const unsigned old = xb_add(&bar[XB_XSUB(b.x)], 1u);
        const unsigned gen = old / nloc;
        if (old + 1u == (gen + 1u) * nloc) {
            __builtin_amdgcn_fence(__ATOMIC_RELEASE, "agent");
            asm volatile("s_waitcnt vmcnt(0)" ::: "memory");
            const unsigned og = xb_add(&bar[XB_TOP], 1u);
            const unsigned tg = og / nx;
            if (og + 1u == (tg + 1u) * nx) xb_add(&bar[XB_TOPGEN], 1u);
            else XB_SPIN(xb_ld(&bar[XB_TOPGEN]) == tg, bar);
            __builtin_amdgcn_fence(__ATOMIC_ACQUIRE, "agent");
            xb_add(&bar[XB_XGEN(b.x)], 1u);
            asm volatile("s_waitcnt vmcnt(0)" ::: "memory");
        } else {
            XB_SPIN(xb_ld(&bar[XB_XGEN(b.x)]) == gen, bar);
            __builtin_amdgcn_fence(__ATOMIC_ACQUIRE, "agent");
            asm volatile("s_waitcnt vmcnt(0)" ::: "memory");
        }
    }
    __syncthreads();
}


typedef const __attribute__((address_space(4))) Args* KArgs;
#if defined(__HIP_DEVICE_COMPILE__)
#define LOAD_ARGS KArgs kp = (KArgs)__builtin_amdgcn_kernarg_segment_ptr(); asm volatile("" : "+s"(kp)); const Args a = *kp;
#else
#define LOAD_ARGS const Args a = a_;
#endif
#ifndef DUP_MASK
#define DUP_MASK 0
#endif
#define PHASE(n, ...) if (ph_lo <= (n) && (n) < ph_hi) for (int rep_ = 0; rep_ < (((DUP_MASK >> (n)) & 1) ? 2 : 1); ++rep_) { if ((n) > ph_lo || rep_) xcd_barrier(xb); LOAD_ARGS \
    unsigned char* ws = a.ws; float* out = a.out; (void)ws; (void)out; \
    bf16_t* XB = (bf16_t*)(ws + W_XB); bf16_t* Hh = (bf16_t*)(ws + W_Q); bf16_t* Uu = (bf16_t*)(ws + W_U); bf16_t* Zz = (bf16_t*)(ws + W_Z); \
    bf16_t* Gt = (bf16_t*)(out + O_Y); bf16_t* Vv = (bf16_t*)(out + O_SSMS); bf16_t* Mm = (bf16_t*)(ws + W_Q); float* M1 = (float*)(ws + W_M1); \
    (void)XB; (void)Hh; (void)Uu; (void)Zz; (void)Gt; (void)Vv; (void)Mm; (void)M1; __VA_ARGS__ }
__global__ void __launch_bounds__(512, 2) mk_fwd(Args a_) {
    extern __shared__ __attribute__((aligned(16))) unsigned char shm[];
    LAS unsigned char* lds = (LAS unsigned char*)shm;
    const int ph_lo = a_.ph_lo, ph_hi = a_.ph_hi;
    volatile LAS unsigned* xst = (volatile LAS unsigned*)(lds + 141312);
    if (threadIdx.x == 0) { xst[0] = 0u; xst[1] = 0u; }
    __syncthreads();
    const XcdBarrier xb = xcd_barrier_post((unsigned*)(a_.ws + W_BAR), xst);
    if (ph_hi == 12345) cg::this_grid().sync();
    PHASE(0, phase_convert(a, lds);)
    PHASE(1, run_gemm(lds, XB, (const bf16_t*)(ws + W_UP1), 2 * DFF, DM, EpiSwiglu{Hh});)
    PHASE(2, run_gemm_res(lds, Hh, (const bf16_t*)(ws + W_DN1), DFF, EpiRes<0>{Zz, a.x_p, a.x_s, nullptr, 0.5f}, out + O_SSMS);)
    PHASE(3, phase_ln(Zz, nullptr, a.ln1g, a.ln1b, XB, out + O_SSMS, DFF / 256, 0.5f, a.x_s, nullptr);)
    PHASE(4, run_gemm(lds, XB, (const bf16_t*)(ws + W_IN), NIN, DM, EpiProj{Uu, Vv, (bf16_t*)(ws + W_Q), Zz, Gt, (bf16_t*)(ws + W_SIDE), (float*)(ws + W_BETA), (float*)(ws + W_GLOG), out + O_CONVP, out + O_CONVS, (float*)(ws + W_STAT),
                                                                      (const float*)(ws + W_BIN), a.alog, a.dtb});)
    PHASE(5, { const bool dry = ((DUP_MASK >> 5) & 1) && rep_ == 0; if (!dry || (DUP_MASK & (1 << 20))) phase_delta_pre(a, lds, dry); if (!dry || (DUP_MASK & (1 << 21))) phase_mix(a, lds, dry); })
    PHASE(6, phase_delta_scan(a, lds);)
    PHASE(7, run_gemm(lds, Zz, (const bf16_t*)(ws + W_BB), DM, DM, EpiM2{Gt, Mm});)
    PHASE(8, run_gemm_res(lds, Mm, (const bf16_t*)(ws + W_WO), DM, EpiRes<1>{Zz, nullptr, nullptr, XB, 1.0f}, (float*)Uu);)
    PHASE(9, phase_ln(Zz, nullptr, a.ln2g, a.ln2b, XB, (const float*)Uu, DM / 256, 1.0f, nullptr, XB);)
    PHASE(10, run_gemm(lds, XB, (const bf16_t*)(ws + W_UP2), 2 * DFF, DM, EpiSwiglu{Hh});)
    PHASE(11, run_gemm_res(lds, Hh, (const bf16_t*)(ws + W_DN2), DFF, EpiRes<1>{Zz, nullptr, nullptr, XB, 0.5f}, (float*)Uu);)
    PHASE(12, phase_ln(Zz, out + O_Y, a.ln3g, a.ln3b, nullptr, (const float*)Uu, DFF / 256, 0.5f, nullptr, XB);)
}

extern "C" void kernel_launch(void* const* d_in, const int* in_sizes, int n_in, void* d_out, int out_size, void* d_ws, size_t ws_size, hipStream_t stream) {
    static int grid = 0;
    if (grid == 0) {
        if (n_in != 27 || (size_t)out_size != O_END || ws_size < W_END) { fprintf(stderr, "kernel_launch: unexpected sizes n_in %d out %d ws %zu (need %zu)\n", n_in, out_size, ws_size, (size_t)W_END); grid = -1; return; }
        int dev = 0, cus = 0, per_cu = 0;
        (void)hipGetDevice(&dev); (void)hipDeviceGetAttribute(&cus, hipDeviceAttributeMultiprocessorCount, dev);
        if (hipFuncSetAttribute((const void*)mk_fwd, hipFuncAttributeMaxDynamicSharedMemorySize, LDS_BYTES) != hipSuccess) { fprintf(stderr, "kernel_launch: hipFuncSetAttribute failed\n"); grid = -1; return; }
        (void)hipOccupancyMaxActiveBlocksPerMultiprocessor(&per_cu, (const void*)mk_fwd, 512, LDS_BYTES);
        if (per_cu < 1) { fprintf(stderr, "kernel_launch: occupancy query gave %d\n", per_cu); per_cu = 1; }
        (void)hipGetLastError();
        grid = cus * 1;
    }
    if (grid < 0) return;
    if (hipMemsetAsync((char*)d_ws + W_BAR, 0, 16384, stream) != hipSuccess) { fprintf(stderr, "kernel_launch: memset of barrier words failed\n"); return; }
    Args a{};
    const float** f = (const float**)&a;
    for (int i = 0; i < 27; ++i) f[i] = (const float*)d_in[i];
    a.out = (float*)d_out; a.ws = (unsigned char*)d_ws;
#if MK_ONE_LAUNCH
    a.ph_lo = 0; a.ph_hi = 13;
    void* args[] = {&a};
    hipError_t e = hipLaunchCooperativeKernel((const void*)mk_fwd, dim3(grid), dim3(512), args, LDS_BYTES, stream);
    if (e != hipSuccess) fprintf(stderr, "cooperative launch failed: %s (grid %d)\n", hipGetErrorString(e), grid);
#else
    for (int ph = 0; ph < 13; ++ph) { a.ph_lo = ph; a.ph_hi = ph + 1; hipLaunchKernelGGL(mk_fwd, dim3(grid), dim3(512), LDS_BYTES, stream, a); }
#endif
}
```

```cpp
#define MK_ONE_LAUNCH 1
#include <hip/hip_runtime.h>
#include <hip/hip_cooperative_groups.h>
#include <cstdio>
namespace cg = cooperative_groups;
namespace pg8 {
#define PG8_LAS __attribute__((address_space(3)))
typedef unsigned short bf16_t;
typedef short bf16x8 __attribute__((ext_vector_type(8)));
typedef float f32x4 __attribute__((ext_vector_type(4)));
typedef unsigned u32x4 __attribute__((ext_vector_type(4)));
constexpr int BM = 256, BK = 64, HALF = 128, HTB = HALF * BK * 2  , STAGE_BYTES = 8 * HTB, NXCD = 8, WGM = 2;

__host__ __device__ __forceinline__ int lds_byte(int r, int c) { const int st = (r >> 4) * 2 + (c >> 5), rr = r & 15, cc = c & 31, ob = rr * 64 + cc * 2; return st * 1024 + (ob ^ (((ob >> 9) & 1) << 5)); }
__host__ __device__ __forceinline__ void stage_rc(int b, int& R, int& C) { const int st = b / 1024, sb = b % 1024, swz = sb ^ (((sb >> 9) & 1) << 5); R = (st >> 1) * 16 + swz / 64; C = (st & 1) * 32 + (swz % 64) / 2; }
__host__ __device__ __forceinline__ int perm32(int rho) { const int n = rho >> 4, i = rho & 15; return 8 * (i >> 2) + 4 * n + (i & 3); }
struct Unit { int pm, pn, kb; };
struct Gemm { const bf16_t* A; const bf16_t* Bt; int M, N, K, KL; };
struct StaticOrder {
    int nM, nN, nwg, G, c;
    __host__ __device__ void init(int M, int N, int G_, int c_) { nM = M / BM; nN = N / BM; nwg = nM * nN; G = G_; c = c_; }
    __host__ __device__ bool next(int i, Unit& u) const {
        const long L = (long)i * G + c; if (L >= nwg) return false;
        int wgid = (int)L; { const int q = nwg / NXCD, r = nwg % NXCD, xcd = wgid % NXCD, off = wgid / NXCD; wgid = (xcd < r ? xcd * (q + 1) : r * (q + 1) + (xcd - r) * q) + off; }
        const int nig = WGM * nN, gid = wgid / nig, fm = gid * WGM, gsz = (nM - fm) < WGM ? (nM - fm) : WGM;
        u.pm = fm + ((wgid % nig) % gsz); u.pn = (wgid % nig) / gsz; u.kb = 0; return true;
    }
    __device__ __forceinline__ void a_ready(const Unit&) const {}
    __device__ __forceinline__ void done(const Unit&) const {}
};
__device__ __forceinline__ unsigned cvt_pk_bf16(float lo, float hi) { unsigned r; asm volatile("v_cvt_pk_bf16_f32 %0, %1, %2" : "=v"(r) : "v"(lo), "v"(hi)); return r; }
template <class Epi, class Sched>
__device__ __forceinline__ void gemm_phase(PG8_LAS unsigned char* lds, const Gemm g, const Sched& S, const Epi& E) {
    const int tid = threadIdx.x, wid = __builtin_amdgcn_readfirstlane(tid >> 6), lane = tid & 63, wr = wid >> 2, wc = wid & 3, fr = lane & 15, fq = lane >> 4;
    const int K = g.K, nt = g.KL / BK;
    unsigned voffA[2], voffB[2];
#pragma unroll
    for (int i = 0; i < 2; ++i) { int R, C; stage_rc(tid * 16 + i * 8192, R, C); const int Rb = Epi::PERM ? ((R & ~31) + perm32(R & 31)) : R;
        voffA[i] = (unsigned)(R * K + C) * 2u; voffB[i] = (unsigned)(Rb * K + C) * 2u; }
    const size_t kstep = (size_t)(BK * 2);
    const size_t hstep = (size_t)HALF * K * 2;
    const size_t tstep = 2 * hstep;
    const unsigned ldsw = (unsigned)wid * 1024u;
    const int aoff = lds_byte(wr * 64 + fr, fq * 8), boff = lds_byte(wc * 32 + fr, fq * 8);
#define PG8_SA(b, h) (((b) * 2 + (h)) * HTB)
#define PG8_SB(b, h) ((4 + (b) * 2 + (h)) * HTB)
#define PG8_STAGE(bufoff, gbase, voff) do { _Pragma("unroll") for (int _i = 0; _i < 2; ++_i) \
        __builtin_amdgcn_global_load_lds((const unsigned*)((const char*)(gbase) + (voff)[_i]), (PG8_LAS unsigned*)(lds + (bufoff) + ldsw + _i * 8192), 16, 0, 0); } while (0)
#define PG8_LDA(dst, b, h) do { _Pragma("unroll") for (int m = 0; m < 4; ++m) _Pragma("unroll") for (int k = 0; k < 2; ++k) dst[m][k] = *(const PG8_LAS bf16x8*)(lds + PG8_SA(b, h) + aoff + m * 2048 + k * 1024); } while (0)
#define PG8_LDB(dst, b, h) do { _Pragma("unroll") for (int n = 0; n < 2; ++n) _Pragma("unroll") for (int k = 0; k < 2; ++k) dst[n][k] = *(const PG8_LAS bf16x8*)(lds + PG8_SB(b, h) + boff + n * 2048 + k * 1024); } while (0)
#define PG8_MMA(ai, bj, At, Bt) do { __builtin_amdgcn_s_setprio(1); _Pragma("unroll") for (int m = 0; m < 4; ++m) _Pragma("unroll") for (int n = 0; n < 2; ++n) _Pragma("unroll") for (int k = 0; k < 2; ++k) \
        acc[ai][bj][m][n] = __builtin_amdgcn_mfma_f32_16x16x32_bf16(Bt[n][k], At[m][k], acc[ai][bj][m][n], 0, 0, 0); __builtin_amdgcn_s_setprio(0); } while (0)
#define PG8_WAIT_V(n) asm volatile("s_waitcnt vmcnt(" #n ")" ::: "memory")
#define PG8_WAIT_L(n) asm volatile("s_waitcnt lgkmcnt(" #n ")" ::: "memory")
#define PG8_BAR __builtin_amdgcn_s_barrier()
#define PG8_SCHED __builtin_amdgcn_sched_barrier(0)
    Unit cur, nxt; int ui = 0;
    if (!S.next(0, cur)) return;
    f32x4 acc[2][2][4][2];
#pragma unroll
    for (int a = 0; a < 2; ++a)
#pragma unroll
        for (int b = 0; b < 2; ++b)
#pragma unroll
            for (int m = 0; m < 4; ++m)
#pragma unroll
                for (int n = 0; n < 2; ++n) acc[a][b][m][n] = (f32x4){0.f, 0.f, 0.f, 0.f};
    bf16x8 At[4][2], B0[2][2], B1[2][2];
    const char* cA = (const char*)g.A + (size_t)cur.pm * tstep + cur.kb; const char* cB = (const char*)g.Bt + (size_t)cur.pn * tstep + cur.kb;
    S.a_ready(cur);
    PG8_STAGE(PG8_SB(0, 0), cB, voffB); PG8_STAGE(PG8_SA(0, 0), cA, voffA); PG8_STAGE(PG8_SB(0, 1), cB + hstep, voffB); PG8_STAGE(PG8_SA(0, 1), cA + hstep, voffA);
    if (wr == 1) PG8_BAR;
    PG8_WAIT_V(4); PG8_BAR;
    PG8_STAGE(PG8_SB(1, 0), cB + kstep, voffB); PG8_STAGE(PG8_SA(1, 0), cA + kstep, voffA); PG8_STAGE(PG8_SB(1, 1), cB + hstep + kstep, voffB);
    PG8_WAIT_V(6); PG8_BAR;
    for (;;) {
        const bool has_next = S.next(ui + 1, nxt);
        const char* nA = has_next ? (const char*)g.A + (size_t)nxt.pm * tstep + nxt.kb : cA; const char* nB = has_next ? (const char*)g.Bt + (size_t)nxt.pn * tstep + nxt.kb : cB;
        for (int t = 0; t < nt; t += 2) {
            const bool last = (t == nt - 2);
            const char* a1 = cA + (size_t)(t + 1) * kstep;
            const char* a2 = last ? nA : cA + (size_t)(t + 2) * kstep; const char* b2 = last ? nB : cB + (size_t)(t + 2) * kstep;
            const char* a3 = a2 + kstep; const char* b3 = b2 + kstep;
            if (last && has_next) S.a_ready(nxt);
            PG8_LDB(B0, 0, 0); PG8_SCHED; PG8_LDA(At, 0, 0); PG8_STAGE(PG8_SA(1, 1), a1 + hstep, voffA);
            PG8_WAIT_L(8); PG8_BAR; PG8_WAIT_L(0); PG8_MMA(0, 0, At, B0); PG8_BAR; PG8_SCHED;
            PG8_LDB(B1, 0, 1); PG8_STAGE(PG8_SB(0, 0), b2, voffB);
            PG8_BAR; PG8_WAIT_L(0); PG8_MMA(0, 1, At, B1); PG8_BAR;
            PG8_LDA(At, 0, 1); PG8_STAGE(PG8_SA(0, 0), a2, voffA);
            PG8_BAR; PG8_WAIT_L(0); PG8_MMA(1, 0, At, B0); PG8_BAR; PG8_SCHED;
            PG8_STAGE(PG8_SB(0, 1), b2 + hstep, voffB);
            PG8_WAIT_V(6); PG8_BAR; PG8_MMA(1, 1, At, B1); PG8_BAR;
            PG8_LDB(B0, 1, 0); PG8_SCHED; PG8_LDA(At, 1, 0); PG8_STAGE(PG8_SA(0, 1), a2 + hstep, voffA);
            PG8_WAIT_L(8); PG8_BAR; PG8_WAIT_L(0); PG8_MMA(0, 0, At, B0); PG8_BAR; PG8_SCHED;
            PG8_LDB(B1, 1, 1); PG8_STAGE(PG8_SB(1, 0), b3, voffB);
            PG8_BAR; PG8_WAIT_L(0); PG8_MMA(0, 1, At, B1); PG8_BAR;
            PG8_LDA(At, 1, 1); PG8_STAGE(PG8_SA(1, 0), a3, voffA);
            PG8_BAR; PG8_WAIT_L(0); PG8_MMA(1, 0, At, B0); PG8_BAR; PG8_SCHED;
            PG8_STAGE(PG8_SB(1, 1), b3 + hstep, voffB);
            PG8_WAIT_V(6); PG8_BAR; PG8_MMA(1, 1, At, B1); PG8_BAR;
        }
        if constexpr (!Epi::AFTER_DRAIN) { E(acc, cur, wr, wc, fr, fq); S.done(cur); }
        if (!has_next) break;
#pragma unroll
        for (int a = 0; a < 2; ++a)
#pragma unroll
            for (int b = 0; b < 2; ++b)
#pragma unroll
                for (int m = 0; m < 4; ++m)
#pragma unroll
                    for (int n = 0; n < 2; ++n) acc[a][b][m][n] = (f32x4){0.f, 0.f, 0.f, 0.f};
        cur = nxt; cA = nA; cB = nB; ++ui;
    }
    PG8_WAIT_V(0);
    if (wr == 0) PG8_BAR;
    PG8_BAR;
    if constexpr (Epi::AFTER_DRAIN) { E.fused(acc, cur, wr, wc, fr, fq, lds, wid, lane); S.done(cur); }
#undef PG8_SA
#undef PG8_SB
#undef PG8_STAGE
#undef PG8_LDA
#undef PG8_LDB
#undef PG8_MMA
#undef PG8_WAIT_V
#undef PG8_WAIT_L
#undef PG8_BAR
#undef PG8_SCHED
}
}
using pg8::bf16_t; using pg8::bf16x8; using pg8::f32x4; using pg8::u32x4;
#define LAS __attribute__((address_space(3)))
typedef float f32x16 __attribute__((ext_vector_type(16)));
typedef unsigned u32x2 __attribute__((ext_vector_type(2)));
#define DI __device__ __forceinline__

constexpr int DM = 1024, MP = 16384, MS = 512, MT = MP + MS, SEQ = 2048, DFF = 2816, NIN = 8448, NQKV = 3072;
constexpr float ALPHA = 1.189207115002721f;
constexpr size_t O_Y = 0, O_CONVP = (size_t)MT * DM, O_SSMP = O_CONVP + 8 * 3 * 3072, O_CONVS = O_SSMP + (size_t)8 * 8 * 128 * 128,
                 O_SSMS = O_CONVS + (size_t)128 * 3 * 3072, O_GMV = O_SSMS + (size_t)128 * 8 * 128 * 128, O_END = O_GMV + (size_t)MS * DM;
constexpr size_t W_UP1 = 0, W_DN1 = W_UP1 + (size_t)2 * DFF * DM * 2, W_IN = W_DN1 + (size_t)DM * DFF * 2, W_BA = W_IN + (size_t)NIN * DM * 2,
                 W_BB = W_BA + (size_t)DM * DM * 2, W_WO = W_BB + (size_t)DM * DM * 2, W_UP2 = W_WO + (size_t)DM * DM * 2, W_DN2 = W_UP2 + (size_t)2 * DFF * DM * 2,
                 W_BIN = W_DN2 + (size_t)DM * DFF * 2, W_BETA = W_BIN + (size_t)NIN * 4, W_GLOG = W_BETA + (size_t)MT * 8 * 4, W_XB = W_GLOG + (size_t)MT * 8 * 4,
                 W_U = W_XB + (size_t)MT * DM * 2, W_Z = W_U + (size_t)MT * DM * 2, W_Q = W_Z + (size_t)MT * DM * 2, W_M1 = W_Q + (size_t)MT * DM * 2,
                 W_STAT = W_Q + (size_t)MT * NQKV * 2, W_BAR = W_STAT + (size_t)MT * 2 * 4, W_END = W_BAR + 16384;
constexpr int LDS_BYTES = pg8::STAGE_BYTES + 12288;

struct Args {
    const float *x_p, *x_s, *st_conv, *st_ssm, *up1, *dn1, *ln1g, *ln1b, *w_in, *b_in, *gmvg, *gmvb, *gmws, *gmbs, *convw, *alog, *dtb, *dnw, *wba, *wbb, *wo, *ln2g, *ln2b, *up2, *dn2, *ln3g, *ln3b;
    float* out; unsigned char* ws; int ph_lo, ph_hi;
};

DI bf16_t f2bf(float x) { unsigned u = __float_as_uint(x); u += 0x7fffu + ((u >> 16) & 1u); return (bf16_t)(u >> 16); }
DI float bf2f(bf16_t b) { return __uint_as_float(((unsigned)b) << 16); }
DI float bflo(unsigned w) { return __uint_as_float(w << 16); }
DI float bfhi(unsigned w) { return __uint_as_float(w & 0xffff0000u); }
DI unsigned pk2(float lo, float hi) { return (unsigned)f2bf(lo) | ((unsigned)f2bf(hi) << 16); }
typedef __bf16 bf2_t __attribute__((ext_vector_type(2)));
typedef float f32x2 __attribute__((ext_vector_type(2)));
DI unsigned cvt2(float lo, float hi) { const f32x2 v = {lo, hi}; return __builtin_bit_cast(unsigned, __builtin_convertvector(v, bf2_t)); }
DI float sigmoidf_(float x) { return __builtin_amdgcn_rcpf(1.0f + __builtin_amdgcn_exp2f(-1.4426950408889634f * x)); }
DI float siluf_(float x) { return x * sigmoidf_(x); }
DI float gelu_tanh(float x) { const float u = 0.7978845608028654f * (x + 0.044715f * x * x * x); return x * sigmoidf_(2.0f * u); }
DI float softplusf_(float x) { return fmaxf(x, 0.f) + log1pf(__expf(-fabsf(x))); }
DI float wave_sum(float v) {
#pragma unroll
    for (int o = 32; o > 0; o >>= 1) v += __shfl_xor(v, o, 64);
    return v;
}

DI int src_col16(int mode, int n16) {
    if (mode == 0) return n16;
    if (mode == 1) { const int tile = n16 >> 8, within = n16 & 255; return (within >> 7) * DFF + tile * 128 + (within & 127); }
    if (n16 < 6144) return n16;
    if (n16 < 8192) return n16 + 16;
    if (n16 < 8208) return n16 - 8192 + 6144;
    return -1;
}
DI void convert_weight(const float* __restrict__ src, int K, int ld, bf16_t* __restrict__ dst, int Nd, int mode, LAS bf16_t* tile, int bi, int G) {
    const int tid = threadIdx.x, tk = K / 64, ntiles = (Nd / 64) * tk, krow = tid >> 3, cseg = tid & 7;
    f32x4 pa = {0.f, 0.f, 0.f, 0.f}, pb = pa;
    auto fetch = [&](int t) { const int n0 = (t / tk) * 64, k0 = (t % tk) * 64; const int sc = src_col16(mode, n0 + (cseg >> 1) * 16);
        pa = (f32x4){0.f, 0.f, 0.f, 0.f}; pb = pa;
        if (sc >= 0) { const float* p = src + (size_t)(k0 + krow) * ld + sc + (cseg & 1) * 8; pa = *(const f32x4*)p; pb = *(const f32x4*)(p + 4); } };
    if (bi < ntiles) fetch(bi);
    for (int t = bi; t < ntiles; t += G) {
        const int n0 = (t / tk) * 64, k0 = (t % tk) * 64;
        const f32x4 a = pa, b = pb;
        if (t + G < ntiles) fetch(t + G);
#pragma unroll
        for (int i = 0; i < 4; ++i) { tile[(cseg * 8 + i) * 72 + krow] = f2bf(a[i]); tile[(cseg * 8 + 4 + i) * 72 + krow] = f2bf(b[i]); }
        __syncthreads();
        { const int nl = tid >> 3, ks = tid & 7; const u32x4 v = *(const LAS u32x4*)(tile + nl * 72 + ks * 8);
          *(u32x4*)(dst + (size_t)(n0 + nl) * K + k0 + ks * 8) = v; }
        __syncthreads();
    }
}
DI void phase_convert(const Args& a, LAS unsigned char* lds) {
    LAS bf16_t* tile = (LAS bf16_t*)lds;
    unsigned char* ws = a.ws;
    const int bi = (int)blockIdx.x, G = (int)gridDim.x;
    convert_weight(a.up1, DM, 2 * DFF, (bf16_t*)(ws + W_UP1), 2 * DFF, 1, tile, bi, G);
    convert_weight(a.dn1, DFF, DM, (bf16_t*)(ws + W_DN1), DM, 0, tile, bi, G);
    {
        convert_weight(a.w_in, DM, 8208, (bf16_t*)(ws + W_IN), NIN, 2, tile, bi, G);
        convert_weight(a.up2, DM, 2 * DFF, (bf16_t*)(ws + W_UP2), 2 * DFF, 1, tile, bi, G);
        convert_weight(a.dn2, DFF, DM, (bf16_t*)(ws + W_DN2), DM, 0, tile, bi, G); }
    convert_weight(a.wba, DM, DM, (bf16_t*)(ws + W_BA), DM, 0, tile, bi, G);
    convert_weight(a.wbb, DM, DM, (bf16_t*)(ws + W_BB), DM, 0, tile, bi, G);
    convert_weight(a.wo, DM, DM, (bf16_t*)(ws + W_WO), DM, 0, tile, bi, G);
    const size_t gt = (size_t)blockIdx.x * blockDim.x + threadIdx.x, gn = (size_t)gridDim.x * blockDim.x;
    float* binr = (float*)(ws + W_BIN);
    for (size_t i = gt; i < (size_t)NIN; i += gn) { const int sc = src_col16(2, (int)i & ~15); binr[i] = sc >= 0 ? a.b_in[sc + ((int)i & 15)] : 0.f; }
    float* stat = (float*)(ws + W_STAT);
    for (size_t i = gt; i < (size_t)MT * 2; i += gn) stat[i] = 0.f;
    bf16_t* xb = (bf16_t*)(ws + W_XB);
    for (size_t i0 = gt; i0 < (size_t)MT * DM / 8; i0 += 4 * gn) {
        f32x4 v0[4], v1[4];
#pragma unroll
        for (int k = 0; k < 4; ++k) { const size_t i = i0 + k * gn; if (i < (size_t)MT * DM / 8) { const size_t e = i * 8; const float* p = e < (size_t)MP * DM ? a.x_p + e : a.x_s + (e - (size_t)MP * DM);
            v0[k] = *(const f32x4*)p; v1[k] = *(const f32x4*)(p + 4); } }
#pragma unroll
        for (int k = 0; k < 4; ++k) { const size_t i = i0 + k * gn; if (i < (size_t)MT * DM / 8) {
            u32x4 w; w.x = cvt2(v0[k][0], v0[k][1]); w.y = cvt2(v0[k][2], v0[k][3]); w.z = cvt2(v1[k][0], v1[k][1]); w.w = cvt2(v1[k][2], v1[k][3]);
            *(u32x4*)(xb + i * 8) = w; } }
    }
}

struct EpiSwiglu {
    static constexpr bool PERM = true, AFTER_DRAIN = false;
    bf16_t* H;
    DI void operator()(const f32x4 (&acc)[2][2][4][2], const pg8::Unit& u, int wr, int wc, int fr, int fq) const {
        const int row0 = u.pm * 256 + wr * 64 + fr, h0 = u.pn * 128 + wc * 32 + 8 * fq;
#pragma unroll
        for (int ai = 0; ai < 2; ++ai)
#pragma unroll
            for (int m = 0; m < 4; ++m) { bf16_t* rowp = H + (size_t)(row0 + ai * 128 + m * 16) * DFF + h0;
                const f32x4 x0 = acc[ai][0][m][0], x1 = acc[ai][0][m][1], g0 = acc[ai][1][m][0], g1 = acc[ai][1][m][1];
                u32x4 w; w.x = cvt2(siluf_(x0[0]) * g0[0], siluf_(x0[1]) * g0[1]); w.y = cvt2(siluf_(x0[2]) * g0[2], siluf_(x0[3]) * g0[3]);
                w.z = cvt2(siluf_(x1[0]) * g1[0], siluf_(x1[1]) * g1[1]); w.w = cvt2(siluf_(x1[2]) * g1[2], siluf_(x1[3]) * g1[3]);
                *(u32x4*)rowp = w; }
    }
};
template <int RES  > struct EpiRes {
    static constexpr bool PERM = false, AFTER_DRAIN = false;
    bf16_t* R; const float* xp; const float* xs; const bf16_t* xb; float scale;
    DI void operator()(const f32x4 (&acc)[2][2][4][2], const pg8::Unit& u, int wr, int wc, int fr, int fq) const {
        const int row0 = u.pm * 256 + wr * 64 + fr, col0 = u.pn * 256 + wc * 32 + 4 * fq;
#pragma unroll
        for (int ai = 0; ai < 2; ++ai)
#pragma unroll
            for (int m = 0; m < 4; ++m) { const int row = row0 + ai * 128 + m * 16;
#pragma unroll
                for (int bj = 0; bj < 2; ++bj)
#pragma unroll
                    for (int n = 0; n < 2; ++n) { const int col = col0 + bj * 128 + n * 16; f32x4 r;
                        if (RES == 0) { const float* p = row < MP ? xp + (size_t)row * DM + col : xs + (size_t)(row - MP) * DM + col; r = *(const f32x4*)p; }
                        else { const u32x2 w = *(const u32x2*)(xb + (size_t)row * DM + col); r = (f32x4){bflo(w.x), bfhi(w.x), bflo(w.y), bfhi(w.y)}; }
                        const f32x4 y = r * ALPHA + acc[ai][bj][m][n] * scale; u32x2 o; o.x = cvt2(y[0], y[1]); o.y = cvt2(y[2], y[3]);
                        *(u32x2*)(R + (size_t)row * DM + col) = o; } }
    }
};
struct EpiProj {
    static constexpr bool PERM = true, AFTER_DRAIN = false;
    bf16_t *U, *V, *QKV, *Z, *G, *side; float *beta, *glog, *convp, *convs, *stat; const float *bias, *alog, *dtb;
    template <int MODE> DI void body(const f32x4 (&acc)[2][2][4][2], int pn, int row0, int wc, int fq) const {
#pragma unroll
        for (int bj = 0; bj < 2; ++bj) {
            const int col = pn * 256 + wc * 32 + 8 * fq + bj * 128;
            const f32x4 b0 = *(const f32x4*)(bias + col), b1 = *(const f32x4*)(bias + col + 4);
#pragma unroll
            for (int ai = 0; ai < 2; ++ai)
#pragma unroll
                for (int m = 0; m < 4; ++m) {
                    const int row = row0 + ai * 128 + m * 16;
                    f32x4 v0 = acc[ai][bj][m][0] + b0, v1 = acc[ai][bj][m][1] + b1;
                    if (MODE == 5) {
                        const int c = col - 8192;
                        if (c == 0) { f32x4 o0, o1;
#pragma unroll
                            for (int j = 0; j < 4; ++j) { o0[j] = sigmoidf_(v0[j]); o1[j] = sigmoidf_(v1[j]); }
                            *(f32x4*)(beta + (size_t)row * 8) = o0; *(f32x4*)(beta + (size_t)row * 8 + 4) = o1; }
                        if (c == 8) { f32x4 o0, o1;
#pragma unroll
                            for (int j = 0; j < 4; ++j) { o0[j] = -__expf(alog[j]) * softplusf_(v0[j] + dtb[j]); o1[j] = -__expf(alog[4 + j]) * softplusf_(v1[j] + dtb[4 + j]); }
                            *(f32x4*)(glog + (size_t)row * 8) = o0; *(f32x4*)(glog + (size_t)row * 8 + 4) = o1; }
                    } else {
                        bf16_t* dst;
                        if (MODE == 0 || MODE == 1) {
#pragma unroll
                            for (int j = 0; j < 4; ++j) { v0[j] = gelu_tanh(v0[j]); v1[j] = gelu_tanh(v1[j]); }
                            if (MODE == 1) {
                                float s = v0[0] + v0[1] + v0[2] + v0[3] + v1[0] + v1[1] + v1[2] + v1[3];
                                float q = v0[0] * v0[0] + v0[1] * v0[1] + v0[2] * v0[2] + v0[3] * v0[3] + v1[0] * v1[0] + v1[1] * v1[1] + v1[2] * v1[2] + v1[3] * v1[3];
                                s += __shfl_xor(s, 16, 64); q += __shfl_xor(q, 16, 64); s += __shfl_xor(s, 32, 64); q += __shfl_xor(q, 32, 64);
                                if (fq == 0) { atomicAdd(stat + (size_t)row * 2, s); atomicAdd(stat + (size_t)row * 2 + 1, q); } }
                            dst = (MODE == 0 ? U + (size_t)row * DM + col : V + (size_t)row * DM + (col - 1024));
                        } else if (MODE == 2) {
                            const int c = col - 2048; dst = QKV + (size_t)row * NQKV + c;
                            float* cp = nullptr;
                            if (row < MP) { const int t = row & (SEQ - 1); if (t >= SEQ - 3) cp = convp + ((size_t)(row >> 11) * 3 + (t - (SEQ - 3))) * NQKV + c; }
                            else { const int r = row - MP, t = r & 3; if (t >= 1) cp = convs + ((size_t)(r >> 2) * 3 + (t - 1)) * NQKV + c; }
                            if (cp) { *(f32x4*)cp = v0; *(f32x4*)(cp + 4) = v1; }
                            if (row < MP) { const int t6 = row & 63, nc = (row >> 6) + 1;
                                if (t6 >= 61 && (nc & 31) != 0) { u32x4 w; w.x = cvt2(v0[0], v0[1]); w.y = cvt2(v0[2], v0[3]); w.z = cvt2(v1[0], v1[1]); w.w = cvt2(v1[2], v1[3]);
                                    *(u32x4*)(side + ((size_t)nc * 3 + (t6 - 61)) * NQKV + c) = w; } }
                        } else if (MODE == 3) {
#pragma unroll
                            for (int j = 0; j < 4; ++j) { v0[j] = siluf_(v0[j]); v1[j] = siluf_(v1[j]); }
                            dst = Z + (size_t)row * DM + (col - 5120);
                        } else {
#pragma unroll
                            for (int j = 0; j < 4; ++j) { v0[j] = sigmoidf_(v0[j]); v1[j] = sigmoidf_(v1[j]); }
                            dst = G + (size_t)row * 2048 + (col - 6144);
                        }
                        u32x4 w; w.x = cvt2(v0[0], v0[1]); w.y = cvt2(v0[2], v0[3]); w.z = cvt2(v1[0], v1[1]); w.w = cvt2(v1[2], v1[3]);
                        *(u32x4*)dst = w;
                    }
                }
        }
    }
    DI void operator()(const f32x4 (&acc)[2][2][4][2], const pg8::Unit& u, int wr, int wc, int fr, int fq) const {
        const int row0 = u.pm * 256 + wr * 64 + fr, pn = u.pn;
        if (pn < 4) body<0>(acc, pn, row0, wc, fq);
        else if (pn < 8) body<1>(acc, pn, row0, wc, fq);
        else if (pn < 20) body<2>(acc, pn, row0, wc, fq);
        else if (pn < 24) body<3>(acc, pn, row0, wc, fq);
        else if (pn < 32) body<4>(acc, pn, row0, wc, fq);
        else body<5>(acc, pn, row0, wc, fq);
    }
};
struct EpiM1 {
    static constexpr bool PERM = false, AFTER_DRAIN = false;
    bf16_t* G;
    DI void operator()(const f32x4 (&acc)[2][2][4][2], const pg8::Unit& u, int wr, int wc, int fr, int fq) const {
        const int row0 = u.pm * 256 + wr * 64 + fr, col0 = u.pn * 256 + wc * 32 + 4 * fq;
#pragma unroll
        for (int ai = 0; ai < 2; ++ai)
#pragma unroll
            for (int m = 0; m < 4; ++m) { const int row = row0 + ai * 128 + m * 16;
#pragma unroll
                for (int bj = 0; bj < 2; ++bj)
#pragma unroll
                    for (int n = 0; n < 2; ++n) { const int col = col0 + bj * 128 + n * 16; bf16_t* p = G + (size_t)row * 2048 + col;
                        const u32x2 w = *(const u32x2*)p; const f32x4 v = (f32x4){bflo(w.x), bfhi(w.x), bflo(w.y), bfhi(w.y)} * acc[ai][bj][m][n];
                        u32x2 o; o.x = cvt2(v[0], v[1]); o.y = cvt2(v[2], v[3]); *(u32x2*)p = o; } asm volatile("" ::: "memory"); }
    }
};
struct EpiM2 {
    static constexpr bool PERM = false, AFTER_DRAIN = false;
    const bf16_t* G; bf16_t* Mm;
    DI void operator()(const f32x4 (&acc)[2][2][4][2], const pg8::Unit& u, int wr, int wc, int fr, int fq) const {
        const int row0 = u.pm * 256 + wr * 64 + fr, col0 = u.pn * 256 + wc * 32 + 4 * fq;
#pragma unroll
        for (int ai = 0; ai < 2; ++ai)
#pragma unroll
            for (int m = 0; m < 4; ++m) { const int row = row0 + ai * 128 + m * 16;
#pragma unroll
                for (int bj = 0; bj < 2; ++bj)
#pragma unroll
                    for (int n = 0; n < 2; ++n) { const int col = col0 + bj * 128 + n * 16; const bf16_t* p = G + (size_t)row * 2048 + col;
                        const u32x2 w1 = *(const u32x2*)p, w = *(const u32x2*)(p + 1024);
                        const f32x4 v = (f32x4){bflo(w1.x), bfhi(w1.x), bflo(w1.y), bfhi(w1.y)} + (f32x4){bflo(w.x), bfhi(w.x), bflo(w.y), bfhi(w.y)} * acc[ai][bj][m][n];
                        u32x2 o; o.x = cvt2(v[0], v[1]); o.y = cvt2(v[2], v[3]);
                        *(u32x2*)(Mm + (size_t)row * DM + col) = o; } asm volatile("" ::: "memory"); }
    }
};
template <class Epi> DI void run_gemm(LAS unsigned char* lds, const bf16_t* A, const bf16_t* Bt, int N, int K, const Epi& E) {
    pg8::Gemm g{A, Bt, MT, N, K, K}; pg8::StaticOrder S; S.init(MT, N, (int)gridDim.x, (int)blockIdx.x);
    pg8::gemm_phase<Epi, pg8::StaticOrder>(lds, g, S, E);
}
struct SplitOrder {
    int nsplit, nsub, G, c;
    DI void init(int K, int G_, int c_) { nsplit = K / 256; nsub = 8 * nsplit; G = G_; c = c_; }
    DI bool next(int i, pg8::Unit& u) const { const int s = i * G + c; if (s >= nsub) return false; const int tile = s / nsplit, ks = s - tile * nsplit; u.pm = MP / 256 + (tile >> 2); u.pn = tile & 3; u.kb = ks * 512; return true; }
    DI void a_ready(const pg8::Unit&) const {}
    DI void done(const pg8::Unit&) const {}
};
struct EpiPartial {
    static constexpr bool PERM = false, AFTER_DRAIN = false;
    float* P;
    DI void operator()(const f32x4 (&acc)[2][2][4][2], const pg8::Unit& u, int wr, int wc, int fr, int fq) const {
        const int row0 = (u.pm - MP / 256) * 256 + wr * 64 + fr, col0 = u.pn * 256 + wc * 32 + 4 * fq; float* base = P + (size_t)(u.kb >> 9) * MS * DM;
#pragma unroll
        for (int ai = 0; ai < 2; ++ai)
#pragma unroll
            for (int m = 0; m < 4; ++m) { float* rowp = base + (size_t)(row0 + ai * 128 + m * 16) * DM + col0;
#pragma unroll
                for (int bj = 0; bj < 2; ++bj)
#pragma unroll
                    for (int n = 0; n < 2; ++n) *(f32x4*)(rowp + bj * 128 + n * 16) = acc[ai][bj][m][n]; }
    }
};
template <class Epi> DI void run_gemm_res(LAS unsigned char* lds, const bf16_t* A, const bf16_t* Bt, int K, const Epi& E, float* P) {
    { pg8::Gemm g{A, Bt, MP, DM, K, K}; pg8::StaticOrder S; S.init(MP, DM, (int)gridDim.x, (int)blockIdx.x); pg8::gemm_phase<Epi, pg8::StaticOrder>(lds, g, S, E); }
    { pg8::Gemm g{A, Bt, MT, DM, K, 256}; SplitOrder S; S.init(K, (int)gridDim.x, (int)blockIdx.x); pg8::gemm_phase<EpiPartial, SplitOrder>(lds, g, S, EpiPartial{P}); }
}

DI void phase_ln(const bf16_t* __restrict__ Rb, float* __restrict__ yout, const float* __restrict__ g, const float* __restrict__ b, bf16_t* __restrict__ xb, const float* P, int nsplit, float scale, const float* xs, const bf16_t* resb) {
    const int lane = threadIdx.x & 63, wv = blockIdx.x * 8 + (threadIdx.x >> 6), nw = gridDim.x * 8;
    f32x4 gg[4], bb[4];
#pragma unroll
    for (int i = 0; i < 4; ++i) { gg[i] = *(const f32x4*)(g + 4 * lane + 256 * i); bb[i] = *(const f32x4*)(b + 4 * lane + 256 * i); }
    for (int row = wv; row < MT; row += nw) {
        f32x4 v[4]; float s = 0.f;
        if (row < MP) {
#pragma unroll
            for (int i = 0; i < 4; ++i) { const u32x2 w = *(const u32x2*)(Rb + (size_t)row * DM + 4 * lane + 256 * i); v[i] = (f32x4){bflo(w.x), bfhi(w.x), bflo(w.y), bfhi(w.y)}; }
        } else {
            const size_t ro = (size_t)(row - MP) * DM + 4 * lane;
#pragma unroll
            for (int i = 0; i < 4; ++i) { v[i] = (f32x4){0.f, 0.f, 0.f, 0.f};
                for (int k = 0; k < nsplit; ++k) v[i] += *(const f32x4*)(P + (size_t)k * MS * DM + ro + 256 * i);
                f32x4 r;
                if (xs) r = *(const f32x4*)(xs + ro + 256 * i);
                else { const u32x2 w = *(const u32x2*)(resb + (size_t)row * DM + 4 * lane + 256 * i); r = (f32x4){bflo(w.x), bfhi(w.x), bflo(w.y), bfhi(w.y)}; }
                v[i] = r * ALPHA + v[i] * scale; }
        }
#pragma unroll
        for (int i = 0; i < 4; ++i) s += v[i][0] + v[i][1] + v[i][2] + v[i][3];
        const float mu = wave_sum(s) * (1.0f / DM); float q = 0.f;
#pragma unroll
        for (int i = 0; i < 4; ++i) { v[i] -= mu; q += v[i][0] * v[i][0] + v[i][1] * v[i][1] + v[i][2] * v[i][2] + v[i][3] * v[i][3]; }
        const float rs = rsqrtf(wave_sum(q) * (1.0f / DM) + 1e-5f);
#pragma unroll
        for (int i = 0; i < 4; ++i) { const f32x4 y = v[i] * rs * gg[i] + bb[i];
            if (xb) { u32x2 w; w.x = pk2(y[0], y[1]); w.y = pk2(y[2], y[3]); *(u32x2*)(xb + (size_t)row * DM + 4 * lane + 256 * i) = w; }
            else *(f32x4*)(yout + (size_t)row * DM + 4 * lane + 256 * i) = y; }
    }
}
DI void phase_vnorm(bf16_t* __restrict__ V, const float* __restrict__ g, const float* __restrict__ b, float* __restrict__ gmv) {
    const int lane = threadIdx.x & 63, wv = blockIdx.x * 8 + (threadIdx.x >> 6), nw = gridDim.x * 8;
    for (int row = wv; row < MT; row += nw) {
        bf16_t* p = V + (size_t)row * DM + 8 * lane; float v[16]; float s = 0.f;
#pragma unroll
        for (int i = 0; i < 2; ++i) { const u32x4 w = *(const u32x4*)(p + 512 * i);
            v[8 * i + 0] = bflo(w.x); v[8 * i + 1] = bfhi(w.x); v[8 * i + 2] = bflo(w.y); v[8 * i + 3] = bfhi(w.y);
            v[8 * i + 4] = bflo(w.z); v[8 * i + 5] = bfhi(w.z); v[8 * i + 6] = bflo(w.w); v[8 * i + 7] = bfhi(w.w); }
#pragma unroll
        for (int i = 0; i < 16; ++i) s += v[i];
        const float mu = wave_sum(s) * (1.0f / DM); float q = 0.f;
#pragma unroll
        for (int i = 0; i < 16; ++i) { v[i] -= mu; q += v[i] * v[i]; }
        const float rs = rsqrtf(wave_sum(q) * (1.0f / DM) + 1e-5f);
#pragma unroll
        for (int i = 0; i < 2; ++i) { const int c = 8 * lane + 512 * i;
            const f32x4 g0 = *(const f32x4*)(g + c), g1 = *(const f32x4*)(g + c + 4), b0 = *(const f32x4*)(b + c), b1 = *(const f32x4*)(b + c + 4);
            f32x4 y0, y1;
#pragma unroll
            for (int j = 0; j < 4; ++j) { y0[j] = v[8 * i + j] * rs * g0[j] + b0[j]; y1[j] = v[8 * i + 4 + j] * rs * g1[j] + b1[j]; }
            u32x4 w; w.x = pk2(y0[0], y0[1]); w.y = pk2(y0[2], y0[3]); w.z = pk2(y1[0], y1[1]); w.w = pk2(y1[2], y1[3]);
            *(u32x4*)(p + 512 * i) = w;
            if (row >= MP) { float* o = gmv + (size_t)(row - MP) * DM + c; *(f32x4*)o = y0; *(f32x4*)(o + 4) = y1; } }
    }
}

DI int crow(int reg, int h) { return (reg & 3) + 8 * (reg >> 2) + 4 * h; }
DI void phase_mix(const Args& a, LAS unsigned char* lds, bool dry) {
    bf16_t* U = (bf16_t*)(a.ws + W_U); const bf16_t* V = (const bf16_t*)(a.out + O_SSMS); const float* stat = (const float*)(a.ws + W_STAT);
    LAS bf16_t* vt = (LAS bf16_t*)lds;
    const int tid0 = threadIdx.x;
#pragma unroll 1
    for (int tile = blockIdx.x; tile < 1024; tile += gridDim.x) {
        int tid = tid0; asm volatile("" : "+v"(tid));
        const int lane = tid & 63, wid = tid >> 6, r = lane & 31, h = lane >> 5, rb = wid >> 1, ch = wid & 1;
        const int g = tile & 7, bc = tile >> 3; const size_t tok0 = (size_t)bc * 128;
        const int t = 32 * rb + r; const float* wrow = a.gmws + ((size_t)g * 128 + t) * 128;
        __syncthreads();
#pragma unroll
        for (int i = 0; i < 4; ++i) { const int e = tid + 512 * i, s = e >> 4, seg = e & 15, cc = g * 128 + seg * 8;
            const u32x4 w = *(const u32x4*)(V + (tok0 + s) * DM + cc);
            const float sm_ = stat[(tok0 + s) * 2], sq_ = stat[(tok0 + s) * 2 + 1], mu = sm_ * (1.0f / DM), rs = rsqrtf(fmaxf(sq_ * (1.0f / DM) - mu * mu, 0.f) + 1e-5f);
            const f32x4 g0 = *(const f32x4*)(a.gmvg + cc), g1 = *(const f32x4*)(a.gmvg + cc + 4), b0 = *(const f32x4*)(a.gmvb + cc), b1 = *(const f32x4*)(a.gmvb + cc + 4);
            u32x4 o;
            o.x = pk2((bflo(w.x) - mu) * rs * g0[0] + b0[0], (bfhi(w.x) - mu) * rs * g0[1] + b0[1]); o.y = pk2((bflo(w.y) - mu) * rs * g0[2] + b0[2], (bfhi(w.y) - mu) * rs * g0[3] + b0[3]);
            o.z = pk2((bflo(w.z) - mu) * rs * g1[0] + b1[0], (bfhi(w.z) - mu) * rs * g1[1] + b1[1]); o.w = pk2((bflo(w.w) - mu) * rs * g1[2] + b1[2], (bfhi(w.w) - mu) * rs * g1[3] + b1[3]);
            *(LAS u32x4*)(vt + s * 136 + seg * 8) = o; }
        __syncthreads();
        f32x16 acc[2];
#pragma unroll
        for (int i = 0; i < 16; ++i) { acc[0][i] = 0.f; acc[1][i] = 0.f; }
#pragma unroll 2
        for (int ks = 0; ks < 2 * rb + 2; ++ks) {
            const int s0 = 16 * ks + 8 * h;
            const f32x4 w0 = *(const f32x4*)(wrow + s0), w1 = *(const f32x4*)(wrow + s0 + 4);
            bf16x8 af;
#pragma unroll
            for (int j = 0; j < 4; ++j) { af[j] = (short)f2bf(s0 + j <= t ? w0[j] : 0.f); af[4 + j] = (short)f2bf(s0 + 4 + j <= t ? w1[j] : 0.f); }
#pragma unroll
            for (int nb = 0; nb < 2; ++nb) { bf16x8 bfr;
#pragma unroll
                for (int j = 0; j < 8; ++j) bfr[j] = (short)vt[(s0 + j) * 136 + 64 * ch + 32 * nb + r];
                acc[nb] = __builtin_amdgcn_mfma_f32_32x32x16_bf16(af, bfr, acc[nb], 0, 0, 0); }
        }
#pragma unroll
        for (int nb = 0; nb < 2; ++nb)
#pragma unroll
            for (int i = 0; i < 16; ++i) { const int tt = 32 * rb + crow(i, h), dd = 64 * ch + 32 * nb + r;
                bf16_t* p = U + (tok0 + tt) * DM + g * 128 + dd; const bf16_t o_ = f2bf(bf2f(*p) * (acc[nb][i] + a.gmbs[g * 128 + tt])); if (!dry) *p = o_; }
    }
    for (int e = blockIdx.x * 512 + tid0; e < 128 * DM; e += gridDim.x * 512) {
        const int sq = e >> 10, c = e & 1023, g = c >> 7; const size_t row0 = (size_t)MP + sq * 4, base = row0 * DM + c;
        const float gg = a.gmvg[c], bb = a.gmvb[c];
        float v[4];
#pragma unroll
        for (int s = 0; s < 4; ++s) { const float sm_ = stat[(row0 + s) * 2], sq_ = stat[(row0 + s) * 2 + 1], mu = sm_ * (1.0f / DM), rs = rsqrtf(fmaxf(sq_ * (1.0f / DM) - mu * mu, 0.f) + 1e-5f);
            const float y = (bf2f(V[base + (size_t)s * DM]) - mu) * rs * gg + bb; if (!dry) a.out[O_GMV + ((size_t)sq * 4 + s) * DM + c] = y; v[s] = y; }
#pragma unroll
        for (int t = 0; t < 4; ++t) { float m = a.gmbs[g * 128 + t];
#pragma unroll
            for (int s = 0; s <= t; ++s) m += a.gmws[((size_t)g * 128 + t) * 128 + s] * v[s];
            bf16_t* p = U + base + (size_t)t * DM; const bf16_t o_ = f2bf(bf2f(*p) * m); if (!dry) *p = o_; }
    }
    __syncthreads();
}

DI void delta_seq_unit(const Args& a, LAS float* sm, int unit) {
    const int tid = threadIdx.x, j = tid & 127, qd = tid >> 7, lane = tid & 63, wid = tid >> 6;
    const bool prompt = unit < 64; const int uu = prompt ? unit : unit - 64, b = uu >> 3, h = uu & 7;
    const int T = prompt ? SEQ : 4; const size_t tok0 = prompt ? (size_t)b * SEQ : (size_t)MP + b * 4;
    const bf16_t* QKV = (const bf16_t*)(a.ws + W_Q); bf16_t* Z = (bf16_t*)(a.ws + W_Z);
    const float* betaA = (const float*)(a.ws + W_BETA); const float* glogA = (const float*)(a.ws + W_GLOG);
    float S[32];
    if (prompt) {
#pragma unroll
        for (int i = 0; i < 32; ++i) S[i] = 0.f;
    } else {
#pragma unroll
        for (int i = 0; i < 32; ++i) S[i] = a.st_ssm[(((size_t)b * 8 + h) * 128 + 32 * qd + i) * 128 + j];
    }
    const int part = tid >> 7, col = (part < 3 ? part : 0) * 1024 + h * 128 + j;
    float r0 = 0.f, r1 = 0.f, r2 = 0.f, cw0 = 0.f, cw1 = 0.f, cw2 = 0.f, cw3 = 0.f;
    if (tid < 384) { cw0 = a.convw[col]; cw1 = a.convw[3072 + col]; cw2 = a.convw[2 * 3072 + col]; cw3 = a.convw[3 * 3072 + col];
        if (!prompt) { r0 = a.st_conv[((size_t)b * 3 + 0) * 3072 + col]; r1 = a.st_conv[((size_t)b * 3 + 1) * 3072 + col]; r2 = a.st_conv[((size_t)b * 3 + 2) * 3072 + col]; } }
    const float dnw = a.dnw[j];
    const bf16_t* qp = QKV + tok0 * NQKV + col;
    float r3n = (tid < 384) ? bf2f(qp[0]) : 0.f;
    float betan = betaA[tok0 * 8 + h], gln = glogA[tok0 * 8 + h];
    float zn = (tid < 128) ? bf2f(Z[tok0 * DM + h * 128 + j]) : 0.f;
    for (int t = 0; t < T; ++t) {
        const size_t tok = tok0 + t;
        const float r3 = r3n, beta = betan, gl = gln, zc = zn;
        if (t + 1 < T) { if (tid < 384) r3n = bf2f(qp[(size_t)(t + 1) * NQKV]); betan = betaA[(tok + 1) * 8 + h]; gln = glogA[(tok + 1) * 8 + h]; if (tid < 128) zn = bf2f(Z[(tok + 1) * DM + h * 128 + j]); }
        if (tid < 384) {
            const float acc = r0 * cw0 + r1 * cw1 + r2 * cw2 + r3 * cw3; r0 = r1; r1 = r2; r2 = r3;
            const float val = siluf_(acc); sm[tid] = val;
            const float ss = wave_sum(val * val); if (lane == 0) sm[384 + wid] = ss;
        }
        __syncthreads();
        const float nq = rsqrtf(sm[384] + sm[385] + 1e-6f) * 0.08838834764831845f, nk = rsqrtf(sm[386] + sm[387] + 1e-6f);
        const float g = __expf(gl);
        float d = 0.f;
#pragma unroll
        for (int i = 0; i < 32; ++i) d += S[i] * sm[128 + 32 * qd + i];
        sm[400 + qd * 128 + j] = d * nk;
        __syncthreads();
        const float dt = sm[400 + j] + sm[528 + j] + sm[656 + j] + sm[784 + j];
        const float vn = beta * (sm[256 + j] - g * dt);
        float o = 0.f;
#pragma unroll
        for (int i = 0; i < 32; ++i) { const float kk = sm[128 + 32 * qd + i] * nk; S[i] = g * S[i] + kk * vn; o += S[i] * sm[32 * qd + i]; }
        sm[1024 + qd * 128 + j] = o * nq;
        __syncthreads();
        float ot = 0.f;
        if (tid < 128) { ot = sm[1024 + j] + sm[1152 + j] + sm[1280 + j] + sm[1408 + j]; const float ss = wave_sum(ot * ot); if (lane == 0) sm[392 + wid] = ss; }
        __syncthreads();
        if (tid < 128) { const float ms = (sm[392] + sm[393]) * (1.0f / 128.0f);
            Z[tok * DM + h * 128 + j] = f2bf(ot * rsqrtf(ms + 1e-6f) * dnw * zc); }
    }
    float* so = a.out + (prompt ? O_SSMP : O_SSMS) + ((size_t)b * 8 + h) * 128 * 128;
#pragma unroll
    for (int i = 0; i < 32; ++i) so[(size_t)(32 * qd + i) * 128 + j] = S[i];
    __syncthreads();
}
DI void phase_delta_seq(const Args& a, LAS unsigned char* lds) {
    for (int unit = blockIdx.x; unit < 64 + 1024; unit += gridDim.x) delta_seq_unit(a, (LAS float*)lds, unit);
}


typedef short s16x4 __attribute__((ext_vector_type(4)));
DI bf16x8 pack8(float a0, float a1, float a2, float a3, float a4, float a5, float a6, float a7) {
    const u32x4 p = {cvt2(a0, a1), cvt2(a2, a3), cvt2(a4, a5), cvt2(a6, a7)}; return __builtin_bit_cast(bf16x8, p); }
template <int S_> DI bf16x8 pack_step(const f32x16& x) { return pack8(x[8 * S_], x[8 * S_ + 1], x[8 * S_ + 2], x[8 * S_ + 3], x[8 * S_ + 4], x[8 * S_ + 5], x[8 * S_ + 6], x[8 * S_ + 7]); }
#define MFMA32(a, b, c) __builtin_amdgcn_mfma_f32_32x32x16_bf16((a), (b), (c), 0, 0, 0)
constexpr size_t W_QKM = W_UP1, W_SIDE = W_UP1 + (size_t)2048 * 3072 * 2, W_TM = W_IN;
static_assert(W_SIDE + (size_t)256 * 3 * NQKV * 2 <= W_IN, "side buffer must fit behind QKm");

template <int PART> DI void conv_vals(const LAS bf16_t* rawt, const LAS float* cwl, int r, int ch, float (&acc)[8]) {
#pragma unroll
    for (int j = 0; j < 8; ++j) acc[j] = 0.f;
#pragma unroll
    for (int i = 0; i < 4; ++i) {
        const u32x4 raw = *(const LAS u32x4*)(rawt + (r + i) * 136 + ch);
        const f32x4 w0 = *(const LAS f32x4*)(cwl + ((PART * 4 + i) * 128 + ch)), w1 = *(const LAS f32x4*)(cwl + ((PART * 4 + i) * 128 + ch + 4));
        acc[0] += bflo(raw.x) * w0[0]; acc[1] += bfhi(raw.x) * w0[1]; acc[2] += bflo(raw.y) * w0[2]; acc[3] += bfhi(raw.y) * w0[3];
        acc[4] += bflo(raw.z) * w1[0]; acc[5] += bfhi(raw.z) * w1[1]; acc[6] += bflo(raw.w) * w1[2]; acc[7] += bfhi(raw.w) * w1[3];
    }
#pragma unroll
    for (int j = 0; j < 8; ++j) acc[j] = siluf_(acc[j]);
}
template <int PART> DI void conv_block(bf16_t* qb, const bf16_t* sb, LAS bf16_t* rawt, const LAS float* cwl, bool first, int h, int mb, int lane, bf16x8 (&frag)[8], bool dry) {
    const int r = lane & 31, hh = lane >> 5, tl = 32 * mb + r, colb = PART * 1024 + h * 128;
#pragma unroll
    for (int it = 0; it < 9; ++it) { const int p = lane + 64 * it, rr = p >> 4, seg = p & 15, tr = 32 * mb - 3 + rr;
        if (p < 560) { u32x4 v = {0u, 0u, 0u, 0u};
            if (tr >= 0) v = *(const u32x4*)(qb + (tr * NQKV + colb + seg * 8));
            else if (!first) v = *(const u32x4*)(sb + ((tr + 3) * NQKV + colb + seg * 8));
            *(LAS u32x4*)(rawt + rr * 136 + seg * 8) = v; } }
    float sc = 1.0f;
    if (PART < 2) {
        float ss = 0.f;
#pragma unroll 2
        for (int ks = 0; ks < 8; ++ks) { float acc[8]; conv_vals<PART>(rawt, cwl, r, 8 * hh + 16 * ks, acc);
#pragma unroll
            for (int j = 0; j < 8; ++j) ss += acc[j] * acc[j]; }
        ss += __shfl_xor(ss, 32, 64); sc = rsqrtf(ss + 1e-6f) * (PART == 0 ? 0.08838834764831845f : 1.0f);
    }
#pragma unroll
    for (int ks = 0; ks < 8; ++ks) {
        float acc[8]; conv_vals<PART>(rawt, cwl, r, 8 * hh + 16 * ks, acc);
        frag[ks] = pack8(acc[0] * sc, acc[1] * sc, acc[2] * sc, acc[3] * sc, acc[4] * sc, acc[5] * sc, acc[6] * sc, acc[7] * sc);
        if (!dry) *(bf16x8*)(qb + (tl * NQKV + colb + 8 * hh + 16 * ks)) = frag[ks];
        if ((ks & 1) == 1) asm volatile("" ::: "memory");
    }
}
DI void phase_delta_pre(const Args& a, LAS unsigned char* lds, bool dry) {
    bf16_t* QKV = (bf16_t*)(a.ws + W_Q); const bf16_t* side = (const bf16_t*)(a.ws + W_SIDE);
    float* glogA = (float*)(a.ws + W_GLOG); const float* betaA = (const float*)(a.ws + W_BETA);
    bf16_t* Tg = (bf16_t*)(a.ws + W_TM); bf16_t* Qg = (bf16_t*)(a.ws + W_QKM);
    const int tid = threadIdx.x, wid = tid >> 6;
    LAS float* Aw0 = (LAS float*)lds + wid * 4096; LAS float* vG0 = (LAS float*)(lds + 131072) + wid * 128; LAS float* cwl = (LAS float*)(lds + 135168);
#pragma unroll 1
    for (int inst = blockIdx.x * 8 + wid; inst < 2048; inst += gridDim.x * 8) {
        int lane = tid & 63; asm volatile("" : "+v"(lane));
        const int r = lane & 31, hh = lane >> 5;
        LAS float* Aw = Aw0; LAS float* vG = vG0; LAS float* vB = vG + 64;
        const int b = inst >> 8, h = (inst >> 5) & 7, c = inst & 31; const size_t tok0 = (size_t)b * SEQ + c * 64;
        __syncthreads();
        for (int e = tid; e < 1536; e += 512) cwl[e] = a.convw[(e >> 7) % 4 * NQKV + (e >> 9) * 1024 + h * 128 + (e & 127)];
        __syncthreads();
        float G = glogA[(tok0 + lane) * 8 + h];
#pragma unroll
        for (int o = 1; o < 64; o <<= 1) { const float t = __shfl_up(G, o, 64); if (lane >= o) G += t; }
        if (!dry) glogA[(tok0 + lane) * 8 + h] = G;
        vG[lane] = G; vB[lane] = betaA[(tok0 + lane) * 8 + h];
        const bool first = (c == 0); bf16_t* qb = QKV + tok0 * NQKV; const bf16_t* sb = side + ((size_t)b * 32 + c) * 3 * NQKV;
        bf16x8 fq[2][8], fk[2][8];
        { bf16x8 fv[8]; conv_block<2>(qb, sb, (LAS bf16_t*)Aw, cwl, first, h, 1, lane, fv, dry); conv_block<2>(qb, sb, (LAS bf16_t*)Aw, cwl, first, h, 0, lane, fv, dry); }
        conv_block<1>(qb, sb, (LAS bf16_t*)Aw, cwl, first, h, 1, lane, fk[1], dry); conv_block<1>(qb, sb, (LAS bf16_t*)Aw, cwl, first, h, 0, lane, fk[0], dry);
        conv_block<0>(qb, sb, (LAS bf16_t*)Aw, cwl, first, h, 1, lane, fq[1], dry); conv_block<0>(qb, sb, (LAS bf16_t*)Aw, cwl, first, h, 0, lane, fq[0], dry);
        f32x16 g00, g10, g11;
#pragma unroll
        for (int i = 0; i < 16; ++i) { g00[i] = 0.f; g10[i] = 0.f; g11[i] = 0.f; }
#pragma unroll
        for (int ks = 0; ks < 8; ++ks) { g00 = MFMA32(fk[0][ks], fk[0][ks], g00); g10 = MFMA32(fk[1][ks], fk[0][ks], g10); g11 = MFMA32(fk[1][ks], fk[1][ks], g11); }
#pragma unroll
        for (int ii = 0; ii < 16; ++ii) {
            const int i0 = crow(ii, hh), i1 = 32 + i0;
            const float G0 = vG[i0], G1 = vG[i1], B0 = vB[i0], B1 = vB[i1], Gr0 = vG[r], Gr1 = vG[32 + r];
            Aw[i0 * 64 + r] = (r < i0) ? B0 * g00[ii] * __expf(G0 - Gr0) : 0.f;
            Aw[i1 * 64 + r] = B1 * g10[ii] * __expf(G1 - Gr0);
            Aw[i1 * 64 + 32 + r] = (r < i0) ? B1 * g11[ii] * __expf(G1 - Gr1) : 0.f;
        }
#pragma unroll
        for (int i = 0; i < 16; ++i) { g00[i] = 0.f; g10[i] = 0.f; g11[i] = 0.f; }
#pragma unroll
        for (int ks = 0; ks < 8; ++ks) { g00 = MFMA32(fq[0][ks], fk[0][ks], g00); g10 = MFMA32(fq[1][ks], fk[0][ks], g10); g11 = MFMA32(fq[1][ks], fk[1][ks], g11); }
        bf16_t* qo = Qg + (size_t)inst * 3072;
#pragma unroll
        for (int ii = 0; ii < 16; ++ii) {
            const int i0 = crow(ii, hh), i1 = 32 + i0;
            const float G0 = vG[i0], G1 = vG[i1], Gr0 = vG[r], Gr1 = vG[32 + r];
            if (!dry) qo[i0 * 32 + r] = f2bf((r <= i0) ? g00[ii] * __expf(G0 - Gr0) : 0.f);
            if (!dry) qo[1024 + i0 * 32 + r] = f2bf(g10[ii] * __expf(G1 - Gr0));
            if (!dry) qo[2048 + i0 * 32 + r] = f2bf((r <= i0) ? g11[ii] * __expf(G1 - Gr1) : 0.f);
        }
#pragma unroll 1
        for (int i = 0; i < 64; i += 2) {
            const LAS float* ar = Aw + i * 64; const LAS float* br = ar + 64;
            float a0 = (lane == i) ? 1.f : 0.f, a1 = 0.f, b0 = (lane == i + 1) ? 1.f : 0.f, b1 = 0.f; int j = 0;
#pragma unroll 2
            for (; j + 4 <= i; j += 4) { const f32x4 a4 = *(const LAS f32x4*)(ar + j), b4 = *(const LAS f32x4*)(br + j);
                const float t0 = Aw[j * 64 + lane], t1 = Aw[(j + 1) * 64 + lane], t2 = Aw[(j + 2) * 64 + lane], t3 = Aw[(j + 3) * 64 + lane];
                a0 -= a4[0] * t0; b0 -= b4[0] * t0; a1 -= a4[1] * t1; b1 -= b4[1] * t1; a0 -= a4[2] * t2; b0 -= b4[2] * t2; a1 -= a4[3] * t3; b1 -= b4[3] * t3; }
            if (j < i) { const float t0 = Aw[j * 64 + lane], t1 = Aw[(j + 1) * 64 + lane];
                a0 -= ar[j] * t0; b0 -= br[j] * t0; a1 -= ar[j + 1] * t1; b1 -= br[j + 1] * t1; }
            const float xi = a0 + a1, ci = br[i], xj = (b0 + b1) - ci * xi;
            Aw[i * 64 + lane] = xi; Aw[(i + 1) * 64 + lane] = xj;
        }
        bf16_t* to = Tg + (size_t)inst * 3072;
#pragma unroll 4
        for (int i = 0; i < 32; ++i) {
            if (lane < 32 && !dry) to[i * 32 + lane] = f2bf(Aw[i * 64 + lane]);
            if (!dry) to[(lane < 32 ? 1024 : 2048) + i * 32 + (lane & 31)] = f2bf(Aw[(32 + i) * 64 + lane]);
        }
    }
}

DI bf16x8 lds_frag(const LAS bf16_t* p) { const u32x2 lo = *(const LAS u32x2*)p, hi = *(const LAS u32x2*)(p + 8); const u32x4 v = {lo.x, lo.y, hi.x, hi.y}; return __builtin_bit_cast(bf16x8, v); }
DI bf16x8 lds_frag_tr(const LAS bf16_t* lo_p) {
    const s16x4 lo = __builtin_amdgcn_ds_read_tr16_b64_v4i16((LAS s16x4*)lo_p), hi = __builtin_amdgcn_ds_read_tr16_b64_v4i16((LAS s16x4*)(lo_p + 8 * 136));
    return __builtin_shufflevector(lo, hi, 0, 1, 2, 3, 4, 5, 6, 7); }
DI void delta_scan_unit(const Args& a, LAS unsigned char* lds, int unit) {
    const int tid0 = threadIdx.x, wid = tid0 >> 6, b = unit >> 3, h = unit & 7, dv0 = 32 * (wid & 3);
    LAS bf16_t* KN = (LAS bf16_t*)lds; LAS bf16_t* QN = (LAS bf16_t*)(lds + 17408); LAS bf16_t* VC = (LAS bf16_t*)(lds + 34816);
    LAS bf16_t* TI = (LAS bf16_t*)(lds + 52224); LAS bf16_t* QI = (LAS bf16_t*)(lds + 61440); LAS float* OT0 = (LAS float*)(lds + 70656); LAS float* VE = (LAS float*)(lds + 138240);
    const bf16_t* QKV = (const bf16_t*)(a.ws + W_Q); const bf16_t* Tg = (const bf16_t*)(a.ws + W_TM); const bf16_t* Qg = (const bf16_t*)(a.ws + W_QKM);
    const float* Gc = (const float*)(a.ws + W_GLOG); const float* betaA = (const float*)(a.ws + W_BETA); bf16_t* Z = (bf16_t*)(a.ws + W_Z);
    f32x16 S[4];
#pragma unroll
    for (int d = 0; d < 4; ++d)
#pragma unroll
        for (int i = 0; i < 16; ++i) S[d][i] = 0.f;
#define NORMALIZE(cc, OTn, lt, zz) do { const size_t tokn = (size_t)b * SEQ + (cc) * 64; const int nrow = (lt) >> 2, nseg = (lt) & 3; \
        bf16_t* zp = Z + (tokn + nrow) * DM + h * 128 + nseg * 32; const LAS float* op = (OTn) + nrow * 132 + nseg * 32; \
        f32x4 ov[8]; float ss = 0.f; \
        _Pragma("unroll") for (int i = 0; i < 8; ++i) { ov[i] = *(const LAS f32x4*)(op + 4 * i); ss += ov[i][0] * ov[i][0] + ov[i][1] * ov[i][1] + ov[i][2] * ov[i][2] + ov[i][3] * ov[i][3]; } \
        ss += __shfl_xor(ss, 1, 64); ss += __shfl_xor(ss, 2, 64); \
        const float sc = rsqrtf(ss * (1.0f / 128.0f) + 1e-6f); \
        _Pragma("unroll") for (int i = 0; i < 4; ++i) { const f32x4 d0 = *(const f32x4*)(a.dnw + nseg * 32 + 8 * i), d1 = *(const f32x4*)(a.dnw + nseg * 32 + 8 * i + 4); const f32x4 o0 = ov[2 * i], o1 = ov[2 * i + 1]; u32x4 w; \
            w.x = cvt2(o0[0] * sc * d0[0] * bflo(zz[i].x), o0[1] * sc * d0[1] * bfhi(zz[i].x)); w.y = cvt2(o0[2] * sc * d0[2] * bflo(zz[i].y), o0[3] * sc * d0[3] * bfhi(zz[i].y)); \
            w.z = cvt2(o1[0] * sc * d1[0] * bflo(zz[i].z), o1[1] * sc * d1[1] * bfhi(zz[i].z)); w.w = cvt2(o1[2] * sc * d1[2] * bflo(zz[i].w), o1[3] * sc * d1[3] * bfhi(zz[i].w)); \
            *(u32x4*)(zp + 8 * i) = w; } } while (0)
    const bool computer = __builtin_amdgcn_readfirstlane(wid) < 4;
#pragma unroll 1
    for (int c = -1; c < 32; ++c) {
        int tid = tid0; asm volatile("" : "+v"(tid));
        const int lane = tid & 63, r = lane & 31, hh = lane >> 5;
        LAS float* OTc = OT0 + (c & 1) * 8448;
        __syncthreads();
        if (computer) {
            if (c >= 0) {
            f32x16 ks[2];
#pragma unroll
            for (int m = 0; m < 2; ++m)
#pragma unroll
                for (int i = 0; i < 16; ++i) ks[m][i] = 0.f;
#pragma unroll
            for (int d = 0; d < 4; ++d) { const bf16x8 sb0 = pack_step<0>(S[d]), sb1 = pack_step<1>(S[d]);
#pragma unroll
                for (int m = 0; m < 2; ++m) { const int off = (32 * m + r) * 136 + 32 * d + 4 * hh;
                    ks[m] = MFMA32(lds_frag(KN + off), sb0, ks[m]); ks[m] = MFMA32(lds_frag(KN + off + 16), sb1, ks[m]); } }
            f32x16 rhs[2];
#pragma unroll
            for (int m = 0; m < 2; ++m)
#pragma unroll
                for (int g4 = 0; g4 < 4; ++g4) { const int rb0 = 32 * m + 8 * g4 + 4 * hh;
                    const f32x4 bt4 = *(const LAS f32x4*)(VE + 64 + rb0), eg4 = *(const LAS f32x4*)(VE + rb0);
                    const s16x4 v4 = __builtin_amdgcn_ds_read_tr16_b64_v4i16((LAS s16x4*)(VC + (rb0 + ((lane & 15) >> 2)) * 136 + dv0 + 16 * ((lane >> 4) & 1) + 4 * (lane & 3)));
#pragma unroll
                    for (int jj = 0; jj < 4; ++jj) rhs[m][4 * g4 + jj] = bt4[jj] * (bf2f((bf16_t)v4[jj]) - eg4[jj] * ks[m][4 * g4 + jj]); }
            bf16x8 Rb[2][2]; Rb[0][0] = pack_step<0>(rhs[0]); Rb[0][1] = pack_step<1>(rhs[0]); Rb[1][0] = pack_step<0>(rhs[1]); Rb[1][1] = pack_step<1>(rhs[1]);
            f32x16 vn[2];
#pragma unroll
            for (int i = 0; i < 16; ++i) { vn[0][i] = 0.f; vn[1][i] = 0.f; }
#pragma unroll
            for (int s = 0; s < 2; ++s) vn[0] = MFMA32(lds_frag(TI + r * 72 + 16 * s + 4 * hh), Rb[0][s], vn[0]);
#pragma unroll
            for (int m = 0; m < 2; ++m)
#pragma unroll
                for (int s = 0; s < 2; ++s) vn[1] = MFMA32(lds_frag(TI + (32 + r) * 72 + 32 * m + 16 * s + 4 * hh), Rb[m][s], vn[1]);
            bf16x8 Vb[2][2]; Vb[0][0] = pack_step<0>(vn[0]); Vb[0][1] = pack_step<1>(vn[0]); Vb[1][0] = pack_step<0>(vn[1]); Vb[1][1] = pack_step<1>(vn[1]);
            f32x16 qs[2];
#pragma unroll
            for (int m = 0; m < 2; ++m)
#pragma unroll
                for (int i = 0; i < 16; ++i) qs[m][i] = 0.f;
#pragma unroll
            for (int d = 0; d < 4; ++d) { const bf16x8 sb0 = pack_step<0>(S[d]), sb1 = pack_step<1>(S[d]);
#pragma unroll
                for (int m = 0; m < 2; ++m) { const int off = (32 * m + r) * 136 + 32 * d + 4 * hh;
                    qs[m] = MFMA32(lds_frag(QN + off), sb0, qs[m]); qs[m] = MFMA32(lds_frag(QN + off + 16), sb1, qs[m]); } }
            f32x16 o[2];
#pragma unroll
            for (int i = 0; i < 16; ++i) { o[0][i] = 0.f; o[1][i] = 0.f; }
#pragma unroll
            for (int s = 0; s < 2; ++s) o[0] = MFMA32(lds_frag(QI + r * 72 + 16 * s + 4 * hh), Vb[0][s], o[0]);
#pragma unroll
            for (int m = 0; m < 2; ++m)
#pragma unroll
                for (int s = 0; s < 2; ++s) o[1] = MFMA32(lds_frag(QI + (32 + r) * 72 + 32 * m + 16 * s + 4 * hh), Vb[m][s], o[1]);
#pragma unroll
            for (int m = 0; m < 2; ++m)
#pragma unroll
                for (int g4 = 0; g4 < 4; ++g4) { const int rb0 = 32 * m + 8 * g4 + 4 * hh; const f32x4 eg4 = *(const LAS f32x4*)(VE + rb0);
#pragma unroll
                    for (int jj = 0; jj < 4; ++jj) OTc[(rb0 + jj) * 132 + dv0 + r] = o[m][4 * g4 + jj] + eg4[jj] * qs[m][4 * g4 + jj]; }
            f32x16 wv[2];
#pragma unroll
            for (int m = 0; m < 2; ++m)
#pragma unroll
                for (int g4 = 0; g4 < 4; ++g4) { const f32x4 ed4 = *(const LAS f32x4*)(VE + 128 + 32 * m + 8 * g4 + 4 * hh);
#pragma unroll
                    for (int jj = 0; jj < 4; ++jj) wv[m][4 * g4 + jj] = vn[m][4 * g4 + jj] * ed4[jj]; }
            bf16x8 Wb[2][2]; Wb[0][0] = pack_step<0>(wv[0]); Wb[0][1] = pack_step<1>(wv[0]); Wb[1][0] = pack_step<0>(wv[1]); Wb[1][1] = pack_step<1>(wv[1]);
            const float eL = VE[63];
            const int i16 = lane & 15, blk = (lane >> 4) & 1, tq = i16 >> 2, tp = i16 & 3;
#pragma unroll
            for (int d = 0; d < 4; ++d) {
#pragma unroll
                for (int i = 0; i < 16; ++i) S[d][i] *= eL;
#pragma unroll
                for (int m = 0; m < 2; ++m)
#pragma unroll
                    for (int s = 0; s < 2; ++s)
                        S[d] = MFMA32(lds_frag_tr(KN + (32 * m + 16 * s + 4 * hh + tq) * 136 + 32 * d + 16 * blk + 4 * tp), Wb[m][s], S[d]);
            }
            }
            __syncthreads();
        } else {
            u32x4 pf[15], zz[4]; float pG = 0.f, pGL = 0.f, pB = 0.f;
            const int ltv = tid - 256, cn = c + 1 < 32 ? c + 1 : 31;
            { const int cp = c > 0 ? c - 1 : 0; const bf16_t* zq = Z + ((size_t)b * SEQ + cp * 64 + (ltv >> 2)) * DM + h * 128 + (ltv & 3) * 32;
#pragma unroll
              for (int i = 0; i < 4; ++i) zz[i] = *(const u32x4*)(zq + 8 * i); }
            const size_t tok1 = (size_t)b * SEQ + cn * 64; const size_t inst = ((size_t)b * 8 + h) * 32 + cn;
            const bf16_t* qb = QKV + tok1 * NQKV + h * 128; const bf16_t* tb = Tg + inst * 3072; const bf16_t* qg = Qg + inst * 3072;
#pragma unroll
            for (int i = 0; i < 12; ++i) { const int p = ltv + 256 * i, part = p >> 10, row = (p & 1023) >> 4, seg = p & 15; pf[i] = *(const u32x4*)(qb + (row * NQKV + part * 1024 + seg * 8)); }
#pragma unroll
            for (int i = 0; i < 3; ++i) { const int p = ltv + 256 * i, m = p >= 384, q = m ? p - 384 : p; pf[12 + i] = *(const u32x4*)((m ? qg : tb) + q * 8); }
            if (ltv < 64) { pG = Gc[(tok1 + ltv) * 8 + h]; pGL = Gc[(tok1 + 63) * 8 + h]; pB = betaA[(tok1 + ltv) * 8 + h]; }
            if (c > 0) NORMALIZE(c - 1, OT0 + ((c - 1) & 1) * 8448, ltv, zz);
            __syncthreads();
            if (c + 1 < 32) {
#pragma unroll
                for (int i = 0; i < 12; ++i) { const int p = ltv + 256 * i, part = p >> 10, row = (p & 1023) >> 4, seg = p & 15;
                    *(LAS u32x4*)((part == 0 ? QN : (part == 1 ? KN : VC)) + row * 136 + seg * 8) = pf[i]; }
#pragma unroll
                for (int i = 0; i < 3; ++i) { const int p = ltv + 256 * i, m = p >= 384, q = m ? p - 384 : p, blk = q >> 7, rr = (q & 127) >> 2, c8 = (q & 3) * 8;
                    *(LAS u32x4*)((m ? QI : TI) + (32 * (blk > 0) + rr) * 72 + 32 * (blk == 2) + c8) = pf[12 + i]; }
                if (ltv < 64) { VE[ltv] = __expf(pG); VE[64 + ltv] = pB; VE[128 + ltv] = __expf(pGL - pG); }
            }
        }
    }
    __syncthreads();
    int tidf = tid0; asm volatile("" : "+v"(tidf));
    if (!computer) { u32x4 zz[4]; const int ltf = tidf - 256; const bf16_t* zq = Z + ((size_t)b * SEQ + 31 * 64 + (ltf >> 2)) * DM + h * 128 + (ltf & 3) * 32;
#pragma unroll
        for (int i = 0; i < 4; ++i) zz[i] = *(const u32x4*)(zq + 8 * i);
        NORMALIZE(31, OT0 + 8448, ltf, zz); }
#undef NORMALIZE
    const int lane = tidf & 63, r = lane & 31, hh = lane >> 5;
    if (wid < 4) { float* so = a.out + O_SSMP + ((size_t)b * 8 + h) * 128 * 128;
#pragma unroll
        for (int d = 0; d < 4; ++d)
#pragma unroll
            for (int ii = 0; ii < 16; ++ii) so[(size_t)(32 * d + crow(ii, hh)) * 128 + dv0 + r] = S[d][ii]; }
    __syncthreads();
}

DI void delta_sample2(const Args& a, LAS float* sm, int pair) {
    const int tid = threadIdx.x, j = tid & 127, qd = tid >> 7, lane = tid & 63, wid = tid >> 6, b = pair >> 2, h0 = (pair & 3) * 2;
    const size_t tok0 = (size_t)MP + b * 4;
    const bf16_t* QKV = (const bf16_t*)(a.ws + W_Q); bf16_t* Z = (bf16_t*)(a.ws + W_Z);
    const float* betaA = (const float*)(a.ws + W_BETA); const float* glogA = (const float*)(a.ws + W_GLOG);
    float S[2][32], r0[2], r1[2], r2[2], cw[2][4], r3n[2], betan[2], gln[2], zn[2];
    const int part = tid >> 7, pc = (part < 3 ? part : 0) * 1024 + j;
#pragma unroll
    for (int u = 0; u < 2; ++u) { const int h = h0 + u, col = pc + h * 128;
        const float* sp = a.st_ssm + (((size_t)b * 8 + h) * 128 + 32 * qd) * 128;
#pragma unroll
        for (int i = 0; i < 32; ++i) S[u][i] = sp[i * 128 + j];
        r0[u] = r1[u] = r2[u] = 0.f; r3n[u] = 0.f; zn[u] = 0.f;
#pragma unroll
        for (int i = 0; i < 4; ++i) cw[u][i] = 0.f;
        if (tid < 384) {
#pragma unroll
            for (int i = 0; i < 4; ++i) cw[u][i] = a.convw[i * NQKV + col];
            r0[u] = a.st_conv[((size_t)b * 3 + 0) * NQKV + col]; r1[u] = a.st_conv[((size_t)b * 3 + 1) * NQKV + col]; r2[u] = a.st_conv[((size_t)b * 3 + 2) * NQKV + col];
            r3n[u] = bf2f(QKV[tok0 * NQKV + col]); }
        betan[u] = betaA[tok0 * 8 + h]; gln[u] = glogA[tok0 * 8 + h];
        if (tid < 128) zn[u] = bf2f(Z[tok0 * DM + h * 128 + j]); }
    const float dnw = a.dnw[j];
#pragma unroll 1
    for (int t = 0; t < 4; ++t) {
        const size_t tok = tok0 + t; float r3[2], beta[2], gl[2], zc[2];
#pragma unroll
        for (int u = 0; u < 2; ++u) { const int h = h0 + u; r3[u] = r3n[u]; beta[u] = betan[u]; gl[u] = gln[u]; zc[u] = zn[u];
            if (t < 3) { if (tid < 384) r3n[u] = bf2f(QKV[(tok + 1) * NQKV + pc + h * 128]); betan[u] = betaA[(tok + 1) * 8 + h]; gln[u] = glogA[(tok + 1) * 8 + h]; if (tid < 128) zn[u] = bf2f(Z[(tok + 1) * DM + h * 128 + j]); } }
        if (tid < 384) {
#pragma unroll
            for (int u = 0; u < 2; ++u) { const float acc = r0[u] * cw[u][0] + r1[u] * cw[u][1] + r2[u] * cw[u][2] + r3[u] * cw[u][3]; r0[u] = r1[u]; r1[u] = r2[u]; r2[u] = r3[u];
                const float val = siluf_(acc); sm[u * 1536 + tid] = val; const float ss = wave_sum(val * val); if (lane == 0) sm[u * 1536 + 384 + wid] = ss; }
        }
        __syncthreads();
        float nq[2], nk[2], g[2];
#pragma unroll
        for (int u = 0; u < 2; ++u) { LAS float* su = sm + u * 1536;
            nq[u] = rsqrtf(su[384] + su[385] + 1e-6f) * 0.08838834764831845f; nk[u] = rsqrtf(su[386] + su[387] + 1e-6f); g[u] = __expf(gl[u]);
            float d = 0.f;
#pragma unroll
            for (int i = 0; i < 32; ++i) d += S[u][i] * su[128 + 32 * qd + i];
            su[400 + qd * 128 + j] = d * nk[u]; }
        __syncthreads();
#pragma unroll
        for (int u = 0; u < 2; ++u) { LAS float* su = sm + u * 1536;
            const float dt = su[400 + j] + su[528 + j] + su[656 + j] + su[784 + j];
            const float vn = beta[u] * (su[256 + j] - g[u] * dt) * nk[u];
            float o = 0.f;
#pragma unroll
            for (int i = 0; i < 32; ++i) { S[u][i] = g[u] * S[u][i] + su[128 + 32 * qd + i] * vn; o += S[u][i] * su[32 * qd + i]; }
            su[1024 + qd * 128 + j] = o * nq[u]; }
        __syncthreads();
        float ot[2] = {0.f, 0.f};
        if (tid < 128) {
#pragma unroll
            for (int u = 0; u < 2; ++u) { LAS float* su = sm + u * 1536; ot[u] = su[1024 + j] + su[1152 + j] + su[1280 + j] + su[1408 + j]; const float ss = wave_sum(ot[u] * ot[u]); if (lane == 0) su[392 + wid] = ss; } }
        __syncthreads();
        if (tid < 128) {
#pragma unroll
            for (int u = 0; u < 2; ++u) { LAS float* su = sm + u * 1536; const float ms = (su[392] + su[393]) * (1.0f / 128.0f);
                Z[tok * DM + (h0 + u) * 128 + j] = f2bf(ot[u] * rsqrtf(ms + 1e-6f) * dnw * zc[u]); } }
    }
#pragma unroll
    for (int u = 0; u < 2; ++u) { float* so = a.out + O_SSMS + (((size_t)b * 8 + h0 + u) * 128 + 32 * qd) * 128;
#pragma unroll
        for (int i = 0; i < 32; ++i) so[i * 128 + j] = S[u][i]; }
    __syncthreads();
}
DI void phase_delta_scan(const Args& a, LAS unsigned char* lds) {
    const int G = (int)gridDim.x, bi = (int)blockIdx.x, nscan = G > 64 ? 64 : 0;
    if (bi < nscan) { delta_scan_unit(a, lds, bi); return; }
    if (nscan == 0) {
#pragma unroll 1
        for (int u = bi; u < 64; u += G) delta_scan_unit(a, lds, u);
    }
#pragma unroll 1
    for (int pair = bi - nscan; pair < 512; pair += G - nscan) delta_sample2(a, (LAS float*)lds, pair);
    { pg8::Gemm g{(const bf16_t*)(a.ws + W_U), (const bf16_t*)(a.ws + W_BA), MT, DM, DM, DM}; pg8::StaticOrder S; S.init(MT, DM, G - nscan, bi - nscan);
      pg8::gemm_phase<EpiM1, pg8::StaticOrder>(lds, g, S, EpiM1{(bf16_t*)(a.out + O_Y)}); }
}

#define XB_TMO      128
#define XB_XCNT(j)  (256  + 64 * (j))
#define XB_XSUB(j)  (1280 + 64 * (j))
#define XB_XGEN(j)  (2304 + 64 * (j))
#define XB_TOP      3328
#define XB_TOPGEN   3392
#define XCD_BAR_WORDS 3456
#define XB_SPIN_CAP (1u << 18)

__device__ __forceinline__ unsigned xb_ld(unsigned* p)              { return __hip_atomic_load(p, __ATOMIC_RELAXED, __HIP_MEMORY_SCOPE_AGENT); }
__device__ __forceinline__ unsigned xb_add(unsigned* p, unsigned v) { return __hip_atomic_fetch_add(p, v, __ATOMIC_RELAXED, __HIP_MEMORY_SCOPE_AGENT); }
__device__ __forceinline__ unsigned xb_xcc_id() { return (unsigned)__builtin_amdgcn_s_getreg((3 << 11) | 20) & 0xFu; }
#define XB_SPIN(cond, bar) do { unsigned _sp = 0; while (cond) { __builtin_amdgcn_s_sleep(1); \
    if ((++_sp & 255u) == 0u) { if (xb_ld(&(bar)[XB_TMO])) break; if (_sp > XB_SPIN_CAP) { atomicAdd(&(bar)[XB_TMO], 1u); break; } } } } while (0)

struct XcdBarrier {
    unsigned* bar; unsigned x;
    volatile LAS unsigned* st;
};

__device__ __forceinline__ XcdBarrier xcd_barrier_post(unsigned* bar, volatile LAS unsigned* st) {
    XcdBarrier b; b.bar = bar; b.x = xb_xcc_id(); b.st = st;
    if (threadIdx.x == 0) (void)xb_add(&bar[XB_XCNT(b.x)], 1u);
    return b;
}
__device__ __forceinline__ void xcd_barrier_complete(unsigned* bar, unsigned x, unsigned& nloc, unsigned& nx) {
    const unsigned G = gridDim.x * gridDim.y * gridDim.z;
    unsigned sum, cnt, mine, sp = 0u;
    for (;;) {
        sum = 0u; cnt = 0u; mine = 0u;
#pragma unroll
        for (unsigned j = 0; j < 16; ++j) { const unsigned c = xb_ld(&bar[XB_XCNT(j)]); sum += c; cnt += (c > 0u) ? 1u : 0u; mine = (j == x) ? c : mine; }
        if (sum == G) break;
        __builtin_amdgcn_s_sleep(1);
        if ((++sp & 255u) == 0u) { if (xb_ld(&bar[XB_TMO])) break; if (sp > XB_SPIN_CAP) { atomicAdd(&bar[XB_TMO], 1u); break; } }
    }
    nloc = mine > 0u ? mine : 1u; nx = cnt > 0u ? cnt : 1u;
}

__device__ __forceinline__ void xcd_barrier(const XcdBarrier& b) {
    asm volatile("s_waitcnt vmcnt(0)" ::: "memory");
    __syncthreads();
    if (threadIdx.x == 0) {
        unsigned* bar = b.bar;
        __builtin_amdgcn_s_waitcnt(0);
        unsigned nloc = b.st[0], nx = b.st[1];
        if (nloc == 0u) { xcd_barrier_complete(bar, b.x, nloc, nx); b.st[0] = nloc; b.st[1] = nx; }
        const unsigned old = xb_add(&bar[XB_XSUB(b.x)], 1u);
        const unsigned gen = old / nloc;
        if (old + 1u == (gen + 1u) * nloc) {
            __builtin_amdgcn_fence(__ATOMIC_RELEASE, "agent");
            asm volatile("s_waitcnt vmcnt(0)" ::: "memory");
            const unsigned og = xb_add(&bar[XB_TOP], 1u);
            const unsigned tg = og / nx;
            if (og + 1u == (tg + 1u) * nx) xb_add(&bar[XB_TOPGEN], 1u);
            else XB_SPIN(xb_ld(&bar[XB_TOPGEN]) == tg, bar);
            __builtin_amdgcn_fence(__ATOMIC_ACQUIRE, "agent");
            xb_add(&bar[XB_XGEN(b.x)], 1u);
            asm volatile("s_waitcnt vmcnt(0)" ::: "memory");
        } else {
            XB_SPIN(xb_ld(&bar[XB_XGEN(b.x)]) == gen, bar);
            __builtin_amdgcn_fence(__ATOMIC_ACQUIRE, "agent");
            asm volatile("s_waitcnt vmcnt(0)" ::: "memory");
        }
    }
    __syncthreads();
}


typedef const __attribute__((address_space(4))) Args* KArgs;
#if defined(__HIP_DEVICE_COMPILE__)
#define LOAD_ARGS KArgs kp = (KArgs)__builtin_amdgcn_kernarg_segment_ptr(); asm volatile("" : "+s"(kp)); const Args a = *kp;
#else
#define LOAD_ARGS const Args a = a_;
#endif
#ifndef DUP_MASK
#define DUP_MASK 0
#endif
#define PHASE(n, ...) if (ph_lo <= (n) && (n) < ph_hi) for (int rep_ = 0; rep_ < (((DUP_MASK >> (n)) & 1) ? 2 : 1); ++rep_) { if ((n) > ph_lo || rep_) xcd_barrier(xb); LOAD_ARGS \
    unsigned char* ws = a.ws; float* out = a.out; (void)ws; (void)out; \
    bf16_t* XB = (bf16_t*)(ws + W_XB); bf16_t* Hh = (bf16_t*)(ws + W_Q); bf16_t* Uu = (bf16_t*)(ws + W_U); bf16_t* Zz = (bf16_t*)(ws + W_Z); \
    bf16_t* Gt = (bf16_t*)(out + O_Y); bf16_t* Vv = (bf16_t*)(out + O_SSMS); bf16_t* Mm = (bf16_t*)(ws + W_Q); float* M1 = (float*)(ws + W_M1); \
    (void)XB; (void)Hh; (void)Uu; (void)Zz; (void)Gt; (void)Vv; (void)Mm; (void)M1; __VA_ARGS__ }
__global__ void __launch_bounds__(512, 2) mk_fwd(Args a_) {
    extern __shared__ __attribute__((aligned(16))) unsigned char shm[];
    LAS unsigned char* lds = (LAS unsigned char*)shm;
    const int ph_lo = a_.ph_lo, ph_hi = a_.ph_hi;
    volatile LAS unsigned* xst = (volatile LAS unsigned*)(lds + 141312);
    if (threadIdx.x == 0) { xst[0] = 0u; xst[1] = 0u; }
    __syncthreads();
    const XcdBarrier xb = xcd_barrier_post((unsigned*)(a_.ws + W_BAR), xst);
    if (ph_hi == 12345) cg::this_grid().sync();
    PHASE(0, phase_convert(a, lds);)
    PHASE(1, run_gemm(lds, XB, (const bf16_t*)(ws + W_UP1), 2 * DFF, DM, EpiSwiglu{Hh});)
    PHASE(2, run_gemm_res(lds, Hh, (const bf16_t*)(ws + W_DN1), DFF, EpiRes<0>{Zz, a.x_p, a.x_s, nullptr, 0.5f}, out + O_SSMS);)
    PHASE(3, phase_ln(Zz, nullptr, a.ln1g, a.ln1b, XB, out + O_SSMS, DFF / 256, 0.5f, a.x_s, nullptr);)
    PHASE(4, run_gemm(lds, XB, (const bf16_t*)(ws + W_IN), NIN, DM, EpiProj{Uu, Vv, (bf16_t*)(ws + W_Q), Zz, Gt, (bf16_t*)(ws + W_SIDE), (float*)(ws + W_BETA), (float*)(ws + W_GLOG), out + O_CONVP, out + O_CONVS, (float*)(ws + W_STAT),
                                                                      (const float*)(ws + W_BIN), a.alog, a.dtb});)
    PHASE(5, { const bool dry = ((DUP_MASK >> 5) & 1) && rep_ == 0; if (!dry || (DUP_MASK & (1 << 20))) phase_delta_pre(a, lds, dry); if (!dry || (DUP_MASK & (1 << 21))) phase_mix(a, lds, dry); })
    PHASE(6, phase_delta_scan(a, lds);)
    PHASE(7, run_gemm(lds, Zz, (const bf16_t*)(ws + W_BB), DM, DM, EpiM2{Gt, Mm});)
    PHASE(8, run_gemm_res(lds, Mm, (const bf16_t*)(ws + W_WO), DM, EpiRes<1>{Zz, nullptr, nullptr, XB, 1.0f}, (float*)Uu);)
    PHASE(9, phase_ln(Zz, nullptr, a.ln2g, a.ln2b, XB, (const float*)Uu, DM / 256, 1.0f, nullptr, XB);)
    PHASE(10, run_gemm(lds, XB, (const bf16_t*)(ws + W_UP2), 2 * DFF, DM, EpiSwiglu{Hh});)
    PHASE(11, run_gemm_res(lds, Hh, (const bf16_t*)(ws + W_DN2), DFF, EpiRes<1>{Zz, nullptr, nullptr, XB, 0.5f}, (float*)Uu);)
    PHASE(12, phase_ln(Zz, out + O_Y, a.ln3g, a.ln3b, nullptr, (const float*)Uu, DFF / 256, 0.5f, nullptr, XB);)
}

extern "C" void kernel_launch(void* const* d_in, const int* in_sizes, int n_in, void* d_out, int out_size, void* d_ws, size_t ws_size, hipStream_t stream) {
    static int grid = 0;
    if (grid == 0) {
        if (n_in != 27 || (size_t)out_size != O_END || ws_size < W_END) { fprintf(stderr, "kernel_launch: unexpected sizes n_in %d out %d ws %zu (need %zu)\n", n_in, out_size, ws_size, (size_t)W_END); grid = -1; return; }
        int dev = 0, cus = 0, per_cu = 0;
        (void)hipGetDevice(&dev); (void)hipDeviceGetAttribute(&cus, hipDeviceAttributeMultiprocessorCount, dev);
        if (hipFuncSetAttribute((const void*)mk_fwd, hipFuncAttributeMaxDynamicSharedMemorySize, LDS_BYTES) != hipSuccess) { fprintf(stderr, "kernel_launch: hipFuncSetAttribute failed\n"); grid = -1; return; }
        (void)hipOccupancyMaxActiveBlocksPerMultiprocessor(&per_cu, (const void*)mk_fwd, 512, LDS_BYTES);
        if (per_cu < 1) { fprintf(stderr, "kernel_launch: occupancy query gave %d\n", per_cu); per_cu = 1; }
        (void)hipGetLastError();
        grid = cus * 1;
    }
    if (grid < 0) return;
    if (hipMemsetAsync((char*)d_ws + W_BAR, 0, 16384, stream) != hipSuccess) { fprintf(stderr, "kernel_launch: memset of barrier words failed\n"); return; }
    Args a{};
    const float** f = (const float**)&a;
    for (int i = 0; i < 27; ++i) f[i] = (const float*)d_in[i];
    a.out = (float*)d_out; a.ws = (unsigned char*)d_ws;
#if MK_ONE_LAUNCH
    a.ph_lo = 0; a.ph_hi = 13;
    void* args[] = {&a};
    hipError_t e = hipLaunchCooperativeKernel((const void*)mk_fwd, dim3(grid), dim3(512), args, LDS_BYTES, stream);
    if (e != hipSuccess) fprintf(stderr, "cooperative launch failed: %s (grid %d)\n", hipGetErrorString(e), grid);
#else
    for (int ph = 0; ph < 13; ++ph) { a.ph_lo = ph; a.ph_hi = ph + 1; hipLaunchKernelGGL(mk_fwd, dim3(grid), dim3(512), LDS_BYTES, stream, a); }
#endif
}
```
